# Optimizing an MI355X kernel written in HIP

```python
import math
import jax, jax.numpy as jnp
from jax import lax
import numpy as np

D_MODEL = 1024
BATCH = 16
SEQ = 2048
DEPTH = 1

E_A = D_MODEL
CONV_K = 31
N_GROUPS_A = 8
E_B = D_MODEL
CHUNK = 128
N_HEADS_B = 8
HEAD_DIM_B = E_B // N_HEADS_B
N_BRANCH = 2
COLS_A_IN = 2 * E_A
COLS_A_GATE = E_A
COLS_B_UV = 2 * E_B
COLS_B_GATE = E_B
COLS_MERGE = N_BRANCH * D_MODEL
D_IN = COLS_A_IN + COLS_A_GATE + COLS_B_UV + COLS_B_GATE + COLS_MERGE
DEEPNORM_ALPHA = (2.0 * DEPTH) ** 0.25
DEEPNORM_BETA = (8.0 * DEPTH) ** -0.25
LN_EPS = 1e-5

kernel_name = "hybrid_conformer_conv_chunked_gmlp_gated_deepnorm"


def _layer_norm(x, g, b):
    xf = x.astype(jnp.float32)
    mu = jnp.mean(xf, axis=-1, keepdims=True)
    var = jnp.mean(jnp.square(xf - mu), axis=-1, keepdims=True)
    y = (xf - mu) * lax.rsqrt(var + LN_EPS)
    return (y * g.astype(jnp.float32) + b.astype(jnp.float32)).astype(x.dtype)


def _group_norm_channels(x, g, b, n_groups):
    shp = x.shape
    xf = x.astype(jnp.float32).reshape(shp[:-1] + (n_groups, shp[-1] // n_groups))
    mu = jnp.mean(xf, axis=-1, keepdims=True)
    var = jnp.mean(jnp.square(xf - mu), axis=-1, keepdims=True)
    y = ((xf - mu) * lax.rsqrt(var + LN_EPS)).reshape(shp)
    return (y * g.astype(jnp.float32) + b.astype(jnp.float32)).astype(x.dtype)


def _conformer_conv_branch(a_in, a_gate, conv_w, conv_b, gn_g, gn_b, w_pa):
    val, gate = jnp.split(a_in, 2, axis=-1)
    h = val * jax.nn.sigmoid(gate)
    h = lax.conv_general_dilated(
        h, conv_w[:, None, :].astype(h.dtype),
        window_strides=(1,), padding=[(CONV_K - 1, 0)],
        dimension_numbers=("NWC", "WIO", "NWC"),
        feature_group_count=E_A) + conv_b
    h = _group_norm_channels(h, gn_g, gn_b, N_GROUPS_A)
    h = jax.nn.silu(h) * jax.nn.silu(a_gate)
    return jnp.einsum("bse,ed->bsd", h, w_pa)


def _chunked_gmlp_branch(b_uv, b_gate, ln_v_g, ln_v_b, w_spatial, b_spatial, w_pb):
    bsz, seq = b_uv.shape[0], b_uv.shape[1]
    z = jax.nn.gelu(b_uv)
    u, v = jnp.split(z, 2, axis=-1)
    v = _layer_norm(v, ln_v_g, ln_v_b)
    v = v.reshape(bsz, seq // CHUNK, CHUNK, N_HEADS_B, HEAD_DIM_B)
    causal = jnp.tril(jnp.ones((CHUNK, CHUNK), dtype=bool))
    ws = jnp.where(causal[None], w_spatial, jnp.zeros((), w_spatial.dtype))
    v_mix = jnp.einsum("hts,bnshd->bnthd", ws, v) + b_spatial.T[None, None, :, :, None]
    s = u * v_mix.reshape(bsz, seq, E_B)
    s = s * jax.nn.silu(b_gate)
    return jnp.einsum("bse,ed->bsd", s, w_pb)


def setup_inputs(seed: int = 0) -> dict:
    key = jax.random.key(seed)
    ks = jax.random.split(key, 20)
    f32 = jnp.float32
    nrm = lambda k, shp, sc: jax.random.normal(k, shp, f32) * sc
    return {
        "x": jax.random.normal(ks[0], (BATCH, SEQ, D_MODEL), f32),
        "w_in": nrm(ks[1], (D_MODEL, D_IN), D_MODEL ** -0.5),
        "b_in": nrm(ks[2], (D_IN,), 0.02),
        "conv_w": nrm(ks[3], (CONV_K, E_A), CONV_K ** -0.5),
        "conv_b": nrm(ks[4], (E_A,), 0.02),
        "gn_g": 1.0 + nrm(ks[5], (E_A,), 0.02),
        "gn_b": nrm(ks[6], (E_A,), 0.02),
        "ln_v_g": 1.0 + nrm(ks[7], (E_B,), 0.02),
        "ln_v_b": nrm(ks[8], (E_B,), 0.02),
        "w_spatial": nrm(ks[9], (N_HEADS_B, CHUNK, CHUNK), CHUNK ** -0.5),
        "b_spatial": 1.0 + nrm(ks[10], (N_HEADS_B, CHUNK), 0.1),
        "w_pa": nrm(ks[11], (E_A, D_MODEL), E_A ** -0.5),
        "w_pb": nrm(ks[12], (E_B, D_MODEL), E_B ** -0.5),
        "w_o": nrm(ks[13], (D_MODEL, D_MODEL), DEEPNORM_BETA * D_MODEL ** -0.5),
        "b_o": nrm(ks[14], (D_MODEL,), 0.02),
        "ln_out_g": 1.0 + nrm(ks[15], (D_MODEL,), 0.02),
        "ln_out_b": nrm(ks[16], (D_MODEL,), 0.02),
    }


def reference(x, w_in, b_in, conv_w, conv_b, gn_g, gn_b, ln_v_g, ln_v_b,
              w_spatial, b_spatial, w_pa, w_pb, w_o, b_o, ln_out_g, ln_out_b):
    splits = np.cumsum([COLS_A_IN, COLS_A_GATE, COLS_B_UV, COLS_B_GATE]).tolist()
    for _ in range(DEPTH):
        proj = jnp.einsum("bsd,dk->bsk", x, w_in) + b_in
        a_in, a_gate, b_uv, b_gate, merge = jnp.split(proj, splits, axis=-1)
        y_a = _conformer_conv_branch(a_in, a_gate, conv_w, conv_b, gn_g, gn_b, w_pa)
        y_b = _chunked_gmlp_branch(b_uv, b_gate, ln_v_g, ln_v_b, w_spatial, b_spatial, w_pb)
        g_a, g_b = jnp.split(jax.nn.sigmoid(merge), 2, axis=-1)
        mixed = g_a * y_a + g_b * y_b
        sub = jnp.einsum("bsd,de->bse", mixed, w_o) + b_o
        x = _layer_norm(DEEPNORM_ALPHA * x + sub, ln_out_g, ln_out_b)
    return x
```

```cpp
#include <hip/hip_runtime.h>
#include <hip/hip_cooperative_groups.h>
#include <cstdio>
#include <cstdint>
namespace cg = cooperative_groups;

#ifndef N_LAUNCHES
#define N_LAUNCHES 6
#endif

#define LAS __attribute__((address_space(3)))
typedef unsigned short bf16_t;
typedef short bf16x8 __attribute__((ext_vector_type(8)));
typedef float f32x4 __attribute__((ext_vector_type(4)));
typedef float f32x2 __attribute__((ext_vector_type(2)));
typedef unsigned u32x4 __attribute__((ext_vector_type(4)));
typedef unsigned u32x2 __attribute__((ext_vector_type(2)));

constexpr int DM = 1024, NTOK = 32768, DIN = 8192;
constexpr float LN_EPS = 1e-5f;
constexpr float ALPHA = 1.189207115002721f;
constexpr int BM = 256, BK = 64, HALF = 128, HTB = HALF * BK * 2, STAGE_BYTES = 8 * HTB, WGM = 8;
constexpr int LDS_BYTES = STAGE_BYTES;
constexpr int KDIM = 1024;

constexpr size_t MiB = (size_t)1 << 20;
constexpr size_t WS_XB = 0, WS_H = 64 * MiB, WS_SA = 128 * MiB, WS_UB = 192 * MiB, WS_V = 256 * MiB, WS_GA = 320 * MiB, WS_GB = 384 * MiB;
constexpr size_t WS_WIN = 448 * MiB, WS_WPA = 464 * MiB, WS_WPB = 466 * MiB, WS_WO = 468 * MiB, WS_WS = 470 * MiB;
constexpr size_t WS_BIAS = WS_WS + 256 * 1024, WS_STAT = WS_BIAS + 256 * 1024, WS_END = 471 * MiB;
constexpr size_t WS_MIX = WS_XB;

struct Args {
    const float* in[17];
    float* out;
    unsigned char* ws;
    int ph_lo, ph_hi;
};

__device__ __forceinline__ unsigned pk2(float lo, float hi) { unsigned r; asm("v_cvt_pk_bf16_f32 %0, %1, %2" : "=v"(r) : "v"(lo), "v"(hi)); return r; }
__device__ __forceinline__ float bf_lo(unsigned u) { return __uint_as_float(u << 16); }
__device__ __forceinline__ float bf_hi(unsigned u) { return __uint_as_float(u & 0xffff0000u); }
__device__ __forceinline__ float fsigmoid(float x) { return __builtin_amdgcn_rcpf(1.0f + __builtin_amdgcn_exp2f(-1.4426950408889634f * x)); }
__device__ __forceinline__ float fsilu(float x) { return x * fsigmoid(x); }
__device__ __forceinline__ float fgelu(float x) { return x * fsigmoid(1.5957691216057308f * (x + 0.044715f * x * x * x)); }
__device__ __forceinline__ float wave_sum(float v) {
#pragma unroll
    for (int o = 1; o < 64; o <<= 1) v += __shfl_xor(v, o);
    return v;
}
__host__ __device__ __forceinline__ int orig_col(int p) {
    const int tile = p >> 8, q = p & 255;
    if (tile < 8) return (q < 128) ? tile * 128 + q : 1024 + tile * 128 + (q - 128);
    if (tile < 16) { const int tt = tile - 8; return (q < 128) ? 3072 + tt * 128 + q : 5120 + tt * 128 + (q - 128); }
    if (tile < 20) return 2048 + (tile - 16) * 256 + q;
    if (tile < 24) return 4096 + (tile - 20) * 256 + q;
    if (tile < 28) return 6144 + (tile - 24) * 256 + q;
    return 7168 + (tile - 28) * 256 + q;
}

__host__ __device__ __forceinline__ int lds_byte(int r, int c) { const int st = (r >> 4) * 2 + (c >> 5), rr = r & 15, cc = c & 31, ob = rr * 64 + cc * 2; return st * 1024 + (ob ^ (((ob >> 9) & 1) << 5)); }
__host__ __device__ __forceinline__ void stage_rc(int b, int& R, int& C) { const int st = b / 1024, sb = b % 1024, swz = sb ^ (((sb >> 9) & 1) << 5); R = (st >> 1) * 16 + swz / 64; C = (st & 1) * 32 + (swz % 64) / 2; }
__host__ __device__ __forceinline__ int perm32(int rho) { const int n = rho >> 4, i = rho & 15; return 8 * (i >> 2) + 4 * n + (i & 3); }

struct Unit { const char* A; const char* B; int pm, pn, kind; };

__device__ __forceinline__ bool tile_order(long L, int nM, int nN, int& pm, int& pn) {
    const int nwg = nM * nN; if (L >= nwg) return false;
    int wgid = (int)L; { const int q = nwg / 8, r = nwg % 8, xcd = wgid % 8, off = wgid / 8; wgid = (xcd < r ? xcd * (q + 1) : r * (q + 1) + (xcd - r) * q) + off; }
    const int nig = WGM * nN, gid = wgid / nig, fm = gid * WGM, gsz = (nM - fm) < WGM ? (nM - fm) : WGM;
    pm = fm + ((wgid % nig) % gsz); pn = (wgid % nig) / gsz; return true;
}
constexpr size_t TSTEP = (size_t)BM * KDIM * 2;

struct SchedSimple {
    const char* A; const char* B; int nM, nN, G, c;
    __device__ __forceinline__ bool next(int i, Unit& u) const {
        if (!tile_order((long)i * G + c, nM, nN, u.pm, u.pn)) return false;
        u.A = A + (size_t)u.pm * TSTEP; u.B = B + (size_t)u.pn * TSTEP; u.kind = 1; return true;
    }
};
struct SchedDual {
    const char *A0, *B0, *A1, *B1; int nM, nN, G, c;
    __device__ __forceinline__ bool next(int i, Unit& u) const {
        if (!tile_order((long)(i >> 1) * G + c, nM, nN, u.pm, u.pn)) return false;
        u.kind = i & 1;
        u.A = (u.kind ? A1 : A0) + (size_t)u.pm * TSTEP; u.B = (u.kind ? B1 : B0) + (size_t)u.pn * TSTEP; return true;
    }
};

template <class Epi, class Sched>
__device__ __forceinline__ void gemm_phase(LAS unsigned char* lds, const Sched& S, const Epi& E) {
    const int tid = threadIdx.x, wid = __builtin_amdgcn_readfirstlane(tid >> 6), lane = tid & 63, wr = wid >> 2, wc = wid & 3, fr = lane & 15, fq = lane >> 4;
    constexpr int K = KDIM, nt = K / BK;
    unsigned voffA[2], voffB[2];
#pragma unroll
    for (int i = 0; i < 2; ++i) { int R, C; stage_rc(tid * 16 + i * 8192, R, C); const int Rb = Epi::PERM ? ((R & ~31) + perm32(R & 31)) : R;
        voffA[i] = (unsigned)(R * K + C) * 2u; voffB[i] = (unsigned)(Rb * K + C) * 2u; }
    constexpr size_t kstep = (size_t)(BK * 2);
    constexpr size_t hstep = (size_t)HALF * K * 2;
    const unsigned ldsw = (unsigned)wid * 1024u;
    const int aoff = lds_byte(wr * 64 + fr, fq * 8), boff = lds_byte(wc * 32 + fr, fq * 8);
#define PG8_SA(b, h) (((b) * 2 + (h)) * HTB)
#define PG8_SB(b, h) ((4 + (b) * 2 + (h)) * HTB)
#define PG8_STAGE(bufoff, gbase, voff) do { _Pragma("unroll") for (int _i = 0; _i < 2; ++_i) \
        __builtin_amdgcn_global_load_lds((const unsigned*)((const char*)(gbase) + (voff)[_i]), (LAS unsigned*)(lds + (bufoff) + ldsw + _i * 8192), 16, 0, 0); } while (0)
#define PG8_LDA(dst, b, h) do { _Pragma("unroll") for (int m = 0; m < 4; ++m) _Pragma("unroll") for (int k = 0; k < 2; ++k) dst[m][k] = *(const LAS bf16x8*)(lds + PG8_SA(b, h) + aoff + m * 2048 + k * 1024); } while (0)
#define PG8_LDB(dst, b, h) do { _Pragma("unroll") for (int n = 0; n < 2; ++n) _Pragma("unroll") for (int k = 0; k < 2; ++k) dst[n][k] = *(const LAS bf16x8*)(lds + PG8_SB(b, h) + boff + n * 2048 + k * 1024); } while (0)
#define PG8_MMA(ai, bj, At, Bt) do { __builtin_amdgcn_s_setprio(1); _Pragma("unroll") for (int m = 0; m < 4; ++m) _Pragma("unroll") for (int n = 0; n < 2; ++n) _Pragma("unroll") for (int k = 0; k < 2; ++k) \
        acc[ai][bj][m][n] = __builtin_amdgcn_mfma_f32_16x16x32_bf16(Bt[n][k], At[m][k], acc[ai][bj][m][n], 0, 0, 0); __builtin_amdgcn_s_setprio(0); } while (0)
#define PG8_WAIT_V(n) asm volatile("s_waitcnt vmcnt(" #n ")" ::: "memory")
#define PG8_WAIT_L(n) asm volatile("s_waitcnt lgkmcnt(" #n ")" ::: "memory")
#define PG8_BAR __builtin_amdgcn_s_barrier()
#define PG8_SCHED __builtin_amdgcn_sched_barrier(0)
    Unit cur, nxt; int ui = 0;
    if (!S.next(0, cur)) return;
    f32x4 acc[2][2][4][2];
#pragma unroll
    for (int a = 0; a < 2; ++a)
#pragma unroll
        for (int b = 0; b < 2; ++b)
#pragma unroll
            for (int m = 0; m < 4; ++m)
#pragma unroll
                for (int n = 0; n < 2; ++n) acc[a][b][m][n] = (f32x4){0.f, 0.f, 0.f, 0.f};
    bf16x8 At[4][2], B0[2][2], B1[2][2];
    const char* cA = cur.A; const char* cB = cur.B;
    PG8_STAGE(PG8_SB(0, 0), cB, voffB); PG8_STAGE(PG8_SB(0, 1), cB + hstep, voffB); PG8_STAGE(PG8_SA(0, 0), cA, voffA); PG8_STAGE(PG8_SA(0, 1), cA + hstep, voffA);
    if (wr == 1) PG8_BAR;
    PG8_WAIT_V(2); PG8_BAR;
    PG8_STAGE(PG8_SB(1, 0), cB + kstep, voffB); PG8_STAGE(PG8_SA(1, 0), cA + kstep, voffA); PG8_STAGE(PG8_SB(1, 1), cB + hstep + kstep, voffB);
    PG8_WAIT_V(6); PG8_BAR;
    for (;;) {
        const bool has_next = S.next(ui + 1, nxt);
        const char* nA = has_next ? nxt.A : cA; const char* nB = has_next ? nxt.B : cB;
        for (int t = 0; t < nt; t += 2) {
            const bool last = (t == nt - 2);
            const char* a1 = cA + (size_t)(t + 1) * kstep;
            const char* a2 = last ? nA : cA + (size_t)(t + 2) * kstep; const char* b2 = last ? nB : cB + (size_t)(t + 2) * kstep;
            const char* a3 = a2 + kstep; const char* b3 = b2 + kstep;
            PG8_LDB(B0, 0, 0); PG8_LDB(B1, 0, 1); PG8_SCHED; PG8_LDA(At, 0, 0); PG8_STAGE(PG8_SA(1, 1), a1 + hstep, voffA);
            PG8_WAIT_V(8); PG8_WAIT_L(0); PG8_BAR; PG8_MMA(0, 0, At, B0); PG8_MMA(0, 1, At, B1); PG8_BAR; PG8_SCHED;
            PG8_LDA(At, 0, 1); PG8_STAGE(PG8_SB(0, 0), b2, voffB); PG8_STAGE(PG8_SB(0, 1), b2 + hstep, voffB); PG8_STAGE(PG8_SA(0, 0), a2, voffA);
            PG8_WAIT_V(8); PG8_WAIT_L(0); PG8_BAR; PG8_MMA(1, 0, At, B0); PG8_MMA(1, 1, At, B1); PG8_BAR; PG8_SCHED;
            PG8_LDB(B0, 1, 0); PG8_LDB(B1, 1, 1); PG8_SCHED; PG8_LDA(At, 1, 0); PG8_STAGE(PG8_SA(0, 1), a2 + hstep, voffA);
            PG8_WAIT_V(8); PG8_WAIT_L(0); PG8_BAR; PG8_MMA(0, 0, At, B0); PG8_MMA(0, 1, At, B1); PG8_BAR; PG8_SCHED;
            PG8_LDA(At, 1, 1); PG8_STAGE(PG8_SB(1, 0), b3, voffB); PG8_STAGE(PG8_SB(1, 1), b3 + hstep, voffB); PG8_STAGE(PG8_SA(1, 0), a3, voffA);
            PG8_WAIT_V(8); PG8_WAIT_L(0); PG8_BAR; PG8_MMA(1, 0, At, B0); PG8_MMA(1, 1, At, B1); PG8_BAR; PG8_SCHED;
        }
        if (wr == 0) PG8_BAR;
        const bool keep = E(acc, cur, wr, wc, fr, fq);
        if (!has_next) break;
        if (!keep) {
#pragma unroll
            for (int a = 0; a < 2; ++a)
#pragma unroll
                for (int b = 0; b < 2; ++b)
#pragma unroll
                    for (int m = 0; m < 4; ++m)
#pragma unroll
                        for (int n = 0; n < 2; ++n) acc[a][b][m][n] = (f32x4){0.f, 0.f, 0.f, 0.f};
        }
        cur = nxt; cA = nA; cB = nB; ++ui;
        if (wr == 1) PG8_BAR;
    }
    PG8_WAIT_V(0);
    PG8_BAR;
#undef PG8_SA
#undef PG8_SB
#undef PG8_STAGE
#undef PG8_LDA
#undef PG8_LDB
#undef PG8_MMA
#undef PG8_WAIT_V
#undef PG8_WAIT_L
#undef PG8_BAR
#undef PG8_SCHED
}

struct EpiP1 {
    static constexpr bool PERM = true;
    const float* biasP; unsigned char* ws;
    __device__ __forceinline__ bool operator()(f32x4 (&acc)[2][2][4][2], const Unit& u, int wr, int wc, int fr, int fq) const {
        const int tile = u.pn;
        const int row0 = u.pm * BM + wr * 64 + fr, qc = wc * 32 + 8 * fq;
        f32x4 bv[2][2];
#pragma unroll
        for (int bj = 0; bj < 2; ++bj)
#pragma unroll
            for (int n = 0; n < 2; ++n) bv[bj][n] = *(const f32x4*)(biasP + tile * 256 + bj * HALF + qc + 4 * n);
        if (tile < 16) {
            bf16_t* O = (bf16_t*)(ws + (tile < 8 ? WS_H : WS_UB)) + (tile & 7) * 128 + qc;
            const bool glu = tile < 8;
#pragma unroll
            for (int ai = 0; ai < 2; ++ai)
#pragma unroll
                for (int m = 0; m < 4; ++m) {
                    bf16_t* rowp = O + (size_t)(row0 + ai * HALF + m * 16) * DM;
                    float o[8];
#pragma unroll
                    for (int n = 0; n < 2; ++n) { const f32x4 a = acc[ai][0][m][n] + bv[0][n], g = acc[ai][1][m][n] + bv[1][n];
#pragma unroll
                        for (int j = 0; j < 4; ++j) o[4 * n + j] = glu ? a[j] * fsigmoid(g[j]) : fgelu(a[j]) * fsilu(g[j]); }
                    u32x4 w; w.x = pk2(o[0], o[1]); w.y = pk2(o[2], o[3]); w.z = pk2(o[4], o[5]); w.w = pk2(o[6], o[7]);
                    *(u32x4*)rowp = w;
                }
        } else {
            const int kind = (tile - 16) >> 2;
            size_t ooff = (size_t)(192 + 64 * kind) * MiB; if (kind == 0) ooff = WS_SA;
            bf16_t* O = (bf16_t*)(ws + ooff) + (tile & 3) * 256 + qc;
#pragma unroll
            for (int ai = 0; ai < 2; ++ai)
#pragma unroll
                for (int m = 0; m < 4; ++m) {
                    bf16_t* rowp = O + (size_t)(row0 + ai * HALF + m * 16) * DM;
#pragma unroll
                    for (int bj = 0; bj < 2; ++bj) {
                        float o[8];
#pragma unroll
                        for (int n = 0; n < 2; ++n) { const f32x4 a = acc[ai][bj][m][n] + bv[bj][n];
#pragma unroll
                            for (int j = 0; j < 4; ++j) o[4 * n + j] = kind == 0 ? fsilu(a[j]) : kind == 1 ? fgelu(a[j]) : fsigmoid(a[j]); }
                        u32x4 w; w.x = pk2(o[0], o[1]); w.y = pk2(o[2], o[3]); w.z = pk2(o[4], o[5]); w.w = pk2(o[6], o[7]);
                        *(u32x4*)(rowp + bj * HALF) = w;
                    }
                }
        }
        return false;
    }
};

struct EpiP3 {
    static constexpr bool PERM = true;
    const bf16_t *GA, *GB; bf16_t* MIX;
    __device__ __forceinline__ bool operator()(f32x4 (&acc)[2][2][4][2], const Unit& u, int wr, int wc, int fr, int fq) const {
        const int row0 = u.pm * BM + wr * 64 + fr, col0 = u.pn * BM + wc * 32 + 8 * fq;
        const bool first = (u.kind == 0);
#pragma unroll
        for (int ai = 0; ai < 2; ++ai)
#pragma unroll
            for (int m = 0; m < 4; ++m) {
                const size_t ro = (size_t)(row0 + ai * HALF + m * 16) * DM + col0;
#pragma unroll
                for (int bj = 0; bj < 2; ++bj) {
                    const u32x4 gb = *(const u32x4*)(GB + ro + bj * HALF);
                    float b[8] = {bf_lo(gb.x), bf_hi(gb.x), bf_lo(gb.y), bf_hi(gb.y), bf_lo(gb.z), bf_hi(gb.z), bf_lo(gb.w), bf_hi(gb.w)};
                    if (first) {
                        const u32x4 ga = *(const u32x4*)(GA + ro + bj * HALF);
                        float a[8] = {bf_lo(ga.x), bf_hi(ga.x), bf_lo(ga.y), bf_hi(ga.y), bf_lo(ga.z), bf_hi(ga.z), bf_lo(ga.w), bf_hi(ga.w)};
#pragma unroll
                        for (int n = 0; n < 2; ++n)
#pragma unroll
                            for (int j = 0; j < 4; ++j) acc[ai][bj][m][n][j] *= a[4 * n + j] * __builtin_amdgcn_rcpf(b[4 * n + j]);
                    } else {
                        float o[8];
#pragma unroll
                        for (int n = 0; n < 2; ++n)
#pragma unroll
                            for (int j = 0; j < 4; ++j) o[4 * n + j] = acc[ai][bj][m][n][j] * b[4 * n + j];
                        u32x4 w; w.x = pk2(o[0], o[1]); w.y = pk2(o[2], o[3]); w.z = pk2(o[4], o[5]); w.w = pk2(o[6], o[7]);
                        *(u32x4*)(MIX + ro + bj * HALF) = w;
                    }
                }
            }
        return first;
    }
};

struct EpiP4 {
    static constexpr bool PERM = false;
    const float *x, *bo; float* out; float* stat;
    __device__ __forceinline__ bool operator()(f32x4 (&acc)[2][2][4][2], const Unit& u, int wr, int wc, int fr, int fq) const {
        const int row0 = u.pm * BM + wr * 64 + fr, col0 = u.pn * BM + wc * 32 + 4 * fq;
        f32x4 bv[2][2];
#pragma unroll
        for (int bj = 0; bj < 2; ++bj)
#pragma unroll
            for (int n = 0; n < 2; ++n) bv[bj][n] = *(const f32x4*)(bo + col0 + bj * HALF + n * 16);
#pragma unroll
        for (int ai = 0; ai < 2; ++ai)
#pragma unroll
            for (int m = 0; m < 4; ++m) {
                const int row = row0 + ai * HALF + m * 16;
                const size_t ro = (size_t)row * DM + col0;
                float s1 = 0.f, s2 = 0.f;
#pragma unroll
                for (int bj = 0; bj < 2; ++bj)
#pragma unroll
                    for (int n = 0; n < 2; ++n) {
                        const f32x4 xv = *(const f32x4*)(x + ro + bj * HALF + n * 16);
                        const f32x4 y = acc[ai][bj][m][n] + bv[bj][n] + ALPHA * xv;
                        *(f32x4*)(out + ro + bj * HALF + n * 16) = y;
                        s1 += (y[0] + y[1]) + (y[2] + y[3]); s2 += (y[0] * y[0] + y[1] * y[1]) + (y[2] * y[2] + y[3] * y[3]);
                    }
                s1 += __shfl_xor(s1, 16); s1 += __shfl_xor(s1, 32); s2 += __shfl_xor(s2, 16); s2 += __shfl_xor(s2, 32);
                if (fq == 0) { __hip_atomic_fetch_add(stat + 2 * row, s1, __ATOMIC_RELAXED, __HIP_MEMORY_SCOPE_AGENT); __hip_atomic_fetch_add(stat + 2 * row + 1, s2, __ATOMIC_RELAXED, __HIP_MEMORY_SCOPE_AGENT); }
            }
        return false;
    }
};

template <bool PERMUTE>
__device__ __forceinline__ void p0_transpose_item(const float* W, int K, int N, bf16_t* WT, LAS float* scr, int item, int lane) {
    const int nblk = N / 32, kb = item / nblk, nb = item % nblk, k0 = 64 * kb, n0 = 32 * nb;
    const int src0 = PERMUTE ? orig_col(n0) : n0;
#pragma unroll 8
    for (int i = 0; i < 32; ++i) { const int kk = 2 * i + (lane >> 5); scr[kk * 33 + (lane & 31)] = W[(size_t)(k0 + kk) * N + src0 + (lane & 31)]; }
    asm volatile("s_waitcnt lgkmcnt(0)" ::: "memory");
    const int c = lane & 7;
#pragma unroll
    for (int j = 0; j < 4; ++j) { const int n = (lane >> 3) + 8 * j; const LAS float* s = scr + (8 * c) * 33 + n;
        u32x4 o; o.x = pk2(s[0 * 33], s[1 * 33]); o.y = pk2(s[2 * 33], s[3 * 33]); o.z = pk2(s[4 * 33], s[5 * 33]); o.w = pk2(s[6 * 33], s[7 * 33]);
        *(u32x4*)(WT + (size_t)(n0 + n) * K + k0 + 8 * c) = o; }
    asm volatile("s_waitcnt lgkmcnt(0)" ::: "memory");
}

__device__ __forceinline__ void p0_prologue(const Args& a, LAS unsigned char* lds, int tid, int wave, int lane) {
    unsigned char* ws = a.ws;
    const size_t gt = (size_t)blockIdx.x * 512 + tid, GT = (size_t)gridDim.x * 512;
    LAS float* scr = (LAS float*)(lds + wave * 16384);
    const int gw = blockIdx.x * 8 + wave, NGW = gridDim.x * 8;
    constexpr int I_IN = (DM / 64) * (DIN / 32), I_SQ = (DM / 64) * (DM / 32);
    for (int it = gw; it < I_IN + 3 * I_SQ; it += NGW) {
        int r = it;
        if (r < I_IN) { p0_transpose_item<true>(a.in[1], DM, DIN, (bf16_t*)(ws + WS_WIN), scr, r, lane); continue; } r -= I_IN;
        if (r < I_SQ) { p0_transpose_item<false>(a.in[11], DM, DM, (bf16_t*)(ws + WS_WPA), scr, r, lane); continue; } r -= I_SQ;
        if (r < I_SQ) { p0_transpose_item<false>(a.in[12], DM, DM, (bf16_t*)(ws + WS_WPB), scr, r, lane); continue; } r -= I_SQ;
        p0_transpose_item<false>(a.in[13], DM, DM, (bf16_t*)(ws + WS_WO), scr, r, lane);
    }
    if (gt < 8 * 128 * 128) { const int t = (int)(gt >> 7) & 127, s = (int)gt & 127; const float w = a.in[9][gt]; ((bf16_t*)(ws + WS_WS))[gt] = (s <= t) ? (bf16_t)(pk2(w, 0.f) & 0xffffu) : (bf16_t)0; }
    if (gt < DIN) ((float*)(ws + WS_BIAS))[gt] = a.in[2][orig_col((int)gt)];
    if (gt < 2 * NTOK) ((float*)(ws + WS_STAT))[gt] = 0.f;
    const f32x4* x4 = (const f32x4*)a.in[0]; u32x4* xb = (u32x4*)(ws + WS_XB);
    for (size_t i = gt; i < (size_t)NTOK * DM / 8; i += GT) {
        const f32x4 p = x4[2 * i], q = x4[2 * i + 1];
        u32x4 o; o.x = pk2(p[0], p[1]); o.y = pk2(p[2], p[3]); o.z = pk2(q[0], q[1]); o.w = pk2(q[2], q[3]);
        xb[i] = o;
    }
}

__device__ __forceinline__ void p2_conv(const Args& a, int chunk, int wave, int lane) {
    const bf16_t* H = (const bf16_t*)(a.ws + WS_H); bf16_t* SA = (bf16_t*)(a.ws + WS_SA);
    const float *conv_w = a.in[3], *conv_b = a.in[4], *gn_g = a.in[5], *gn_b = a.in[6];
    const bool has_prev = (chunk & 15) != 0;
    const long R0 = (long)chunk * 128;
    const int t0 = wave * 16;
    for (int g = 0; g < 8; ++g) {
        const int c = g * 128 + 2 * lane;
        f32x2 w[31];
#pragma unroll
        for (int j = 0; j < 31; ++j) w[j] = *(const f32x2*)(conv_w + j * DM + c);
        const f32x2 cb = *(const f32x2*)(conv_b + c);
        f32x2 acc[16];
#pragma unroll
        for (int t = 0; t < 16; ++t) acc[t] = cb;
#pragma unroll
        for (int idx = 0; idx < 46; ++idx) {
            const int tok = t0 - 30 + idx;
            unsigned raw = 0u;
            if (tok >= 0 || has_prev) raw = *(const unsigned*)(H + (R0 + tok) * DM + c);
            const f32x2 hv = {bf_lo(raw), bf_hi(raw)};
#pragma unroll
            for (int t = 0; t < 16; ++t) { const int j = idx - t; if (j >= 0 && j <= 30) acc[t] += w[j] * hv; }
        }
        const f32x2 gg = *(const f32x2*)(gn_g + c), gb = *(const f32x2*)(gn_b + c);
#pragma unroll
        for (int t = 0; t < 16; ++t) {
            const float s1 = wave_sum(acc[t].x + acc[t].y), s2 = wave_sum(acc[t].x * acc[t].x + acc[t].y * acc[t].y);
            const float mean = s1 * (1.f / 128.f), var = fmaxf(s2 * (1.f / 128.f) - mean * mean, 0.f), rstd = __builtin_amdgcn_rsqf(var + LN_EPS);
            const float y0 = (acc[t].x - mean) * rstd * gg.x + gb.x, y1 = (acc[t].y - mean) * rstd * gg.y + gb.y;
            unsigned* p = (unsigned*)(SA + (R0 + t0 + t) * DM + c);
            const unsigned sraw = *p;
            *p = pk2(fsilu(y0) * bf_lo(sraw), fsilu(y1) * bf_hi(sraw));
        }
    }
}

__device__ __forceinline__ void p2_gmlp(const Args& a, LAS unsigned char* lds, int chunk, int tid, int wave, int lane) {
    const bf16_t* V = (const bf16_t*)(a.ws + WS_V); bf16_t* UB = (bf16_t*)(a.ws + WS_UB); const bf16_t* WsB = (const bf16_t*)(a.ws + WS_WS);
    const float *ln_g = a.in[7], *ln_b = a.in[8], *b_sp = a.in[10];
    LAS float* mu = (LAS float*)lds; LAS float* rs = mu + 128;
    LAS unsigned char* vt = lds + 1024;
    const long R0 = (long)chunk * 128;
    const int t0 = wave * 16;
#pragma unroll 1
    for (int tt = 0; tt < 16; tt += 4) {
        u32x4 r[4][2];
#pragma unroll
        for (int q = 0; q < 4; ++q) { const bf16_t* row = V + (R0 + t0 + tt + q) * DM; r[q][0] = *(const u32x4*)(row + lane * 8); r[q][1] = *(const u32x4*)(row + 512 + lane * 8); }
#pragma unroll
        for (int q = 0; q < 4; ++q) {
            float s1 = 0.f, s2 = 0.f;
#pragma unroll
            for (int k = 0; k < 2; ++k)
#pragma unroll
                for (int e = 0; e < 4; ++e) { const float lo = bf_lo(r[q][k][e]), hi = bf_hi(r[q][k][e]); s1 += lo + hi; s2 += lo * lo + hi * hi; }
            s1 = wave_sum(s1); s2 = wave_sum(s2);
            const float mean = s1 * (1.f / 1024.f), var = fmaxf(s2 * (1.f / 1024.f) - mean * mean, 0.f);
            if (lane == 0) { mu[t0 + tt + q] = mean; rs[t0 + tt + q] = __builtin_amdgcn_rsqf(var + LN_EPS); }
        }
    }
    __syncthreads();
    const int d = tid & 127, sgq = tid >> 7;
    const int wt = wave >> 1, wd = wave & 1, fr = lane & 15, fq = lane >> 4;
#pragma unroll 1
    for (int h = 0; h < 8; ++h) {
        LAS unsigned char* buf = vt + (h & 1) * 32768;
        const float g = ln_g[h * 128 + d], be = ln_b[h * 128 + d];
#pragma unroll
        for (int i = 0; i < 4; ++i) {
            const int sg = sgq * 4 + i;
            const bf16_t* src = V + (R0 + sg * 8) * DM + h * 128 + d;
            unsigned raw[8];
#pragma unroll
            for (int e = 0; e < 8; ++e) raw[e] = src[(size_t)e * DM];
            float v[8];
#pragma unroll
            for (int e = 0; e < 8; ++e) v[e] = (__uint_as_float(raw[e] << 16) - mu[sg * 8 + e]) * rs[sg * 8 + e] * g + be;
            u32x4 o; o.x = pk2(v[0], v[1]); o.y = pk2(v[2], v[3]); o.z = pk2(v[4], v[5]); o.w = pk2(v[6], v[7]);
            *(LAS u32x4*)(buf + d * 256 + ((sg + d) & 15) * 16) = o;
        }
        __syncthreads();
        f32x4 acc[2][4];
#pragma unroll
        for (int mi = 0; mi < 2; ++mi)
#pragma unroll
            for (int ni = 0; ni < 4; ++ni) acc[mi][ni] = (f32x4){0.f, 0.f, 0.f, 0.f};
        for (int ks = 0; ks <= wt; ++ks) {
            bf16x8 wf[2], vf[4];
#pragma unroll
            for (int mi = 0; mi < 2; ++mi) wf[mi] = *(const bf16x8*)(WsB + (size_t)((h * 128 + 32 * wt + 16 * mi + fr) * 128 + ks * 32 + fq * 8));
#pragma unroll
            for (int ni = 0; ni < 4; ++ni) { const int dd = 64 * wd + 16 * ni + fr; vf[ni] = *(const LAS bf16x8*)(buf + dd * 256 + (((ks * 4 + fq) + dd) & 15) * 16); }
#pragma unroll
            for (int mi = 0; mi < 2; ++mi)
#pragma unroll
                for (int ni = 0; ni < 4; ++ni) acc[mi][ni] = __builtin_amdgcn_mfma_f32_16x16x32_bf16(vf[ni], wf[mi], acc[mi][ni], 0, 0, 0);
        }
#pragma unroll
        for (int mi = 0; mi < 2; ++mi) {
            const int t = 32 * wt + 16 * mi + fr;
            const float bsp = b_sp[h * 128 + t];
#pragma unroll
            for (int ni = 0; ni < 4; ++ni) {
                u32x2* p = (u32x2*)(UB + (R0 + t) * DM + h * 128 + 64 * wd + 16 * ni + 4 * fq);
                const u32x2 ub = *p;
                u32x2 o; o.x = pk2((acc[mi][ni][0] + bsp) * bf_lo(ub.x), (acc[mi][ni][1] + bsp) * bf_hi(ub.x));
                o.y = pk2((acc[mi][ni][2] + bsp) * bf_lo(ub.y), (acc[mi][ni][3] + bsp) * bf_hi(ub.y));
                *p = o;
            }
        }
    }
    __syncthreads();
}

__device__ __forceinline__ void p5_ln(const Args& a, int wave, int lane) {
    const float* stat = (const float*)(a.ws + WS_STAT);
    const f32x4* g4 = (const f32x4*)a.in[15]; const f32x4* b4 = (const f32x4*)a.in[16];
    f32x4 gg[4], bb[4];
#pragma unroll
    for (int j = 0; j < 4; ++j) { gg[j] = g4[lane + 64 * j]; bb[j] = b4[lane + 64 * j]; }
    for (int row = blockIdx.x * 8 + wave; row < NTOK; row += gridDim.x * 8) {
        const float s1 = stat[2 * row], s2 = stat[2 * row + 1];
        const float mean = s1 * (1.f / 1024.f), var = fmaxf(s2 * (1.f / 1024.f) - mean * mean, 0.f), rstd = __builtin_amdgcn_rsqf(var + LN_EPS);
        f32x4* p = (f32x4*)(a.out + (size_t)row * DM) + lane;
        f32x4 v[4];
#pragma unroll
        for (int j = 0; j < 4; ++j) v[j] = p[64 * j];
#pragma unroll
        for (int j = 0; j < 4; ++j) p[64 * j] = (v[j] - mean) * rstd * gg[j] + bb[j];
    }
}

__global__ void __launch_bounds__(512) fwd_megakernel(Args a) {
    extern __shared__ __attribute__((aligned(16))) unsigned char lds_raw[];
    LAS unsigned char* lds = (LAS unsigned char*)lds_raw;
    cg::grid_group grid = cg::this_grid();
    const int tid = threadIdx.x, lane = tid & 63, wave = __builtin_amdgcn_readfirstlane(tid >> 6);
    const int G = gridDim.x, c = blockIdx.x;
    unsigned char* ws = a.ws;
    const int lo = a.ph_lo, hi = a.ph_hi;
#define IN(k) (lo <= (k) && (k) < hi)
#define SEAM(k) do { if (IN(k) && IN((k) + 1)) grid.sync(); } while (0)

    if (IN(0)) { p0_prologue(a, lds, tid, wave, lane); }
    SEAM(0);
    if (IN(1)) {
        SchedSimple S{(const char*)(ws + WS_XB), (const char*)(ws + WS_WIN), NTOK / BM, DIN / BM, G, c};
        EpiP1 E{(const float*)(ws + WS_BIAS), ws};
        gemm_phase(lds, S, E);
    }
    SEAM(1);
    if (IN(2)) {
        for (int chunk = c; chunk < NTOK / 128; chunk += G) { p2_gmlp(a, lds, chunk, tid, wave, lane); p2_conv(a, chunk, wave, lane); }
    }
    SEAM(2);
    if (IN(3)) {
        SchedDual S{(const char*)(ws + WS_SA), (const char*)(ws + WS_WPA), (const char*)(ws + WS_UB), (const char*)(ws + WS_WPB), NTOK / BM, DM / BM, G, c};
        EpiP3 E{(const bf16_t*)(ws + WS_GA), (const bf16_t*)(ws + WS_GB), (bf16_t*)(ws + WS_MIX)};
        gemm_phase(lds, S, E);
    }
    SEAM(3);
    if (IN(4)) {
        SchedSimple S{(const char*)(ws + WS_MIX), (const char*)(ws + WS_WO), NTOK / BM, DM / BM, G, c};
        EpiP4 E{a.in[0], a.in[14], a.out, (float*)(ws + WS_STAT)};
        gemm_phase(lds, S, E);
    }
    SEAM(4);
    if (IN(5)) { p5_ln(a, wave, lane); }
}

extern "C" void kernel_launch(void* const* d_in, const int* in_sizes, int n_in, void* d_out, int out_size, void* d_ws, size_t ws_size, hipStream_t stream) {
    static int grid = 0;
    if (grid == 0) {
        if (n_in != 17 || in_sizes[0] != NTOK * DM || out_size != NTOK * DM || ws_size < WS_END) {
            fprintf(stderr, "kernel_launch: unexpected shapes (n_in %d, in0 %d, out %d, ws %zu < %zu); nothing launched\n", n_in, n_in > 0 ? in_sizes[0] : -1, out_size, ws_size, (size_t)WS_END); grid = -1; return; }
        int dev = 0, cus = 0, per_cu = 0;
        (void)hipGetDevice(&dev);
        (void)hipDeviceGetAttribute(&cus, hipDeviceAttributeMultiprocessorCount, dev);
        if (hipFuncSetAttribute((const void*)fwd_megakernel, hipFuncAttributeMaxDynamicSharedMemorySize, LDS_BYTES) != hipSuccess) { fprintf(stderr, "kernel_launch: hipFuncSetAttribute failed\n"); grid = -1; return; }
        if (hipOccupancyMaxActiveBlocksPerMultiprocessor(&per_cu, (const void*)fwd_megakernel, 512, LDS_BYTES) != hipSuccess || per_cu < 1) { fprintf(stderr, "kernel_launch: occupancy query failed (%d)\n", per_cu); (void)hipGetLastError(); per_cu = 1; }
        if (per_cu > 1) per_cu = 1;
        grid = cus * per_cu;
    }
    if (grid < 0) return;
    Args a{};
    for (int i = 0; i < 17; ++i) a.in[i] = (const float*)d_in[i];
    a.out = (float*)d_out; a.ws = (unsigned char*)d_ws;
#if N_LAUNCHES == 1
    a.ph_lo = 0; a.ph_hi = 6;
    void* args[] = {&a};
    hipError_t e = hipLaunchCooperativeKernel((const void*)fwd_megakernel, dim3(grid), dim3(512), args, LDS_BYTES, stream);
    if (e != hipSuccess) fprintf(stderr, "cooperative launch failed: %s (grid %d)\n", hipGetErrorString(e), grid);
#else
    for (int ph = 0; ph < 6; ++ph) {
        a.ph_lo = ph; a.ph_hi = ph + 1;
        hipLaunchKernelGGL(fwd_megakernel, dim3(grid), dim3(512), LDS_BYTES, stream, a);
    }
#endif
}
```

```cpp
#include <hip/hip_runtime.h>
#include <hip/hip_cooperative_groups.h>
#include <cstdio>
#include <cstdint>
namespace cg = cooperative_groups;

#ifndef N_LAUNCHES
#define N_LAUNCHES 1
#endif

#define LAS __attribute__((address_space(3)))
typedef unsigned short bf16_t;
typedef short bf16x8 __attribute__((ext_vector_type(8)));
typedef float f32x4 __attribute__((ext_vector_type(4)));
typedef float f32x2 __attribute__((ext_vector_type(2)));
typedef unsigned u32x4 __attribute__((ext_vector_type(4)));
typedef unsigned u32x2 __attribute__((ext_vector_type(2)));

constexpr int DM = 1024, NTOK = 32768, DIN = 8192;
constexpr float LN_EPS = 1e-5f;
constexpr float ALPHA = 1.189207115002721f;
constexpr int BM = 256, BK = 64, HALF = 128, HTB = HALF * BK * 2, STAGE_BYTES = 8 * HTB, WGM = 8;
constexpr int LDS_BYTES = STAGE_BYTES;
constexpr int KDIM = 1024;

constexpr size_t MiB = (size_t)1 << 20;
constexpr size_t WS_XB = 0, WS_H = 64 * MiB, WS_SA = 128 * MiB, WS_UB = 192 * MiB, WS_V = 256 * MiB, WS_GA = 320 * MiB, WS_GB = 384 * MiB;
constexpr size_t WS_WIN = 448 * MiB, WS_WPA = 464 * MiB, WS_WPB = 466 * MiB, WS_WO = 468 * MiB, WS_WS = 470 * MiB;
constexpr size_t WS_BIAS = WS_WS + 256 * 1024, WS_STAT = WS_BIAS + 256 * 1024, WS_END = 471 * MiB;
constexpr size_t WS_MIX = WS_XB;

struct Args {
    const float* in[17];
    float* out;
    unsigned char* ws;
    int ph_lo, ph_hi;
};

__device__ __forceinline__ unsigned pk2(float lo, float hi) { unsigned r; asm("v_cvt_pk_bf16_f32 %0, %1, %2" : "=v"(r) : "v"(lo), "v"(hi)); return r; }
__device__ __forceinline__ float bf_lo(unsigned u) { return __uint_as_float(u << 16); }
__device__ __forceinline__ float bf_hi(unsigned u) { return __uint_as_float(u & 0xffff0000u); }
__device__ __forceinline__ float fsigmoid(float x) { return __builtin_amdgcn_rcpf(1.0f + __builtin_amdgcn_exp2f(-1.4426950408889634f * x)); }
__device__ __forceinline__ float fsilu(float x) { return x * fsigmoid(x); }
__device__ __forceinline__ float fgelu(float x) { return x * fsigmoid(1.5957691216057308f * (x + 0.044715f * x * x * x)); }
__device__ __forceinline__ float wave_sum(float v) {
#pragma unroll
    for (int o = 1; o < 64; o <<= 1) v += __shfl_xor(v, o);
    return v;
}
__host__ __device__ __forceinline__ int orig_col(int p) {
    const int tile = p >> 8, q = p & 255;
    if (tile < 8) return (q < 128) ? tile * 128 + q : 1024 + tile * 128 + (q - 128);
    if (tile < 16) { const int tt = tile - 8; return (q < 128) ? 3072 + tt * 128 + q : 5120 + tt * 128 + (q - 128); }
    if (tile < 20) return 2048 + (tile - 16) * 256 + q;
    if (tile < 24) return 4096 + (tile - 20) * 256 + q;
    if (tile < 28) return 6144 + (tile - 24) * 256 + q;
    return 7168 + (tile - 28) * 256 + q;
}

__host__ __device__ __forceinline__ int lds_byte(int r, int c) { const int st = (r >> 4) * 2 + (c >> 5), rr = r & 15, cc = c & 31, ob = rr * 64 + cc * 2; return st * 1024 + (ob ^ (((ob >> 9) & 1) << 5)); }
__host__ __device__ __forceinline__ void stage_rc(int b, int& R, int& C) { const int st = b / 1024, sb = b % 1024, swz = sb ^ (((sb >> 9) & 1) << 5); R = (st >> 1) * 16 + swz / 64; C = (st & 1) * 32 + (swz % 64) / 2; }
__host__ __device__ __forceinline__ int perm32(int rho) { const int n = rho >> 4, i = rho & 15; return 8 * (i >> 2) + 4 * n + (i & 3); }

struct Unit { const char* A; const char* B; int pm, pn, kind; };

__device__ __forceinline__ bool tile_order(long L, int nM, int nN, int& pm, int& pn) {
    const int nwg = nM * nN; if (L >= nwg) return false;
    int wgid = (int)L; { const int q = nwg / 8, r = nwg % 8, xcd = wgid % 8, off = wgid / 8; wgid = (xcd < r ? xcd * (q + 1) : r * (q + 1) + (xcd - r) * q) + off; }
    const int nig = WGM * nN, gid = wgid / nig, fm = gid * WGM, gsz = (nM - fm) < WGM ? (nM - fm) : WGM;
    pm = fm + ((wgid % nig) % gsz); pn = (wgid % nig) / gsz; return true;
}
constexpr size_t TSTEP = (size_t)BM * KDIM * 2;

struct SchedSimple {
    const char* A; const char* B; int nM, nN, G, c;
    __device__ __forceinline__ bool next(int i, Unit& u) const {
        if (!tile_order((long)i * G + c, nM, nN, u.pm, u.pn)) return false;
        u.A = A + (size_t)u.pm * TSTEP; u.B = B + (size_t)u.pn * TSTEP; u.kind = 1; return true;
    }
};
struct SchedDual {
    const char *A0, *B0, *A1, *B1; int nM, nN, G, c;
    __device__ __forceinline__ bool next(int i, Unit& u) const {
        if (!tile_order((long)(i >> 1) * G + c, nM, nN, u.pm, u.pn)) return false;
        u.kind = i & 1;
        u.A = (u.kind ? A1 : A0) + (size_t)u.pm * TSTEP; u.B = (u.kind ? B1 : B0) + (size_t)u.pn * TSTEP; return true;
    }
};

template <class Epi, class Sched>
__device__ __forceinline__ void gemm_phase(LAS unsigned char* lds, const Sched& S, const Epi& E) {
    const int tid = threadIdx.x, wid = __builtin_amdgcn_readfirstlane(tid >> 6), lane = tid & 63, wr = wid >> 2, wc = wid & 3, fr = lane & 15, fq = lane >> 4;
    constexpr int K = KDIM, nt = K / BK;
    unsigned voffA[2], voffB[2];
#pragma unroll
    for (int i = 0; i < 2; ++i) { int R, C; stage_rc(tid * 16 + i * 8192, R, C); const int Rb = Epi::PERM ? ((R & ~31) + perm32(R & 31)) : R;
        voffA[i] = (unsigned)(R * K + C) * 2u; voffB[i] = (unsigned)(Rb * K + C) * 2u; }
    constexpr size_t kstep = (size_t)(BK * 2);
    constexpr size_t hstep = (size_t)HALF * K * 2;
    const unsigned ldsw = (unsigned)wid * 1024u;
    const int aoff = lds_byte(wr * 64 + fr, fq * 8), boff = lds_byte(wc * 32 + fr, fq * 8);
#define PG8_SA(b, h) (((b) * 2 + (h)) * HTB)
#define PG8_SB(b, h) ((4 + (b) * 2 + (h)) * HTB)
#define PG8_STAGE(bufoff, gbase, voff) do { _Pragma("unroll") for (int _i = 0; _i < 2; ++_i) \
        __builtin_amdgcn_global_load_lds((const unsigned*)((const char*)(gbase) + (voff)[_i]), (LAS unsigned*)(lds + (bufoff) + ldsw + _i * 8192), 16, 0, 0); } while (0)
#define PG8_LDA(dst, b, h) do { _Pragma("unroll") for (int m = 0; m < 4; ++m) _Pragma("unroll") for (int k = 0; k < 2; ++k) dst[m][k] = *(const LAS bf16x8*)(lds + PG8_SA(b, h) + aoff + m * 2048 + k * 1024); } while (0)
#define PG8_LDB(dst, b, h) do { _Pragma("unroll") for (int n = 0; n < 2; ++n) _Pragma("unroll") for (int k = 0; k < 2; ++k) dst[n][k] = *(const LAS bf16x8*)(lds + PG8_SB(b, h) + boff + n * 2048 + k * 1024); } while (0)
#define PG8_MMA(ai, bj, At, Bt) do { __builtin_amdgcn_s_setprio(1); _Pragma("unroll") for (int m = 0; m < 4; ++m) _Pragma("unroll") for (int n = 0; n < 2; ++n) _Pragma("unroll") for (int k = 0; k < 2; ++k) \
        acc[ai][bj][m][n] = __builtin_amdgcn_mfma_f32_16x16x32_bf16(Bt[n][k], At[m][k], acc[ai][bj][m][n], 0, 0, 0); __builtin_amdgcn_s_setprio(0); } while (0)
#define PG8_WAIT_V(n) asm volatile("s_waitcnt vmcnt(" #n ")" ::: "memory")
#define PG8_WAIT_L(n) asm volatile("s_waitcnt lgkmcnt(" #n ")" ::: "memory")
#define PG8_BAR __builtin_amdgcn_s_barrier()
#define PG8_SCHED __builtin_amdgcn_sched_barrier(0)
    Unit cur, nxt; int ui = 0;
    if (!S.next(0, cur)) return;
    f32x4 acc[2][2][4][2];
#pragma unroll
    for (int a = 0; a < 2; ++a)
#pragma unroll
        for (int b = 0; b < 2; ++b)
#pragma unroll
            for (int m = 0; m < 4; ++m)
#pragma unroll
                for (int n = 0; n < 2; ++n) acc[a][b][m][n] = (f32x4){0.f, 0.f, 0.f, 0.f};
    bf16x8 At[4][2], B0[2][2], B1[2][2];
    const char* cA = cur.A; const char* cB = cur.B;
    PG8_STAGE(PG8_SB(0, 0), cB, voffB); PG8_STAGE(PG8_SB(0, 1), cB + hstep, voffB); PG8_STAGE(PG8_SA(0, 0), cA, voffA); PG8_STAGE(PG8_SA(0, 1), cA + hstep, voffA);
    if (wr == 1) PG8_BAR;
    PG8_WAIT_V(2); PG8_BAR;
    PG8_STAGE(PG8_SB(1, 0), cB + kstep, voffB); PG8_STAGE(PG8_SA(1, 0), cA + kstep, voffA); PG8_STAGE(PG8_SB(1, 1), cB + hstep + kstep, voffB);
    PG8_WAIT_V(6); PG8_BAR;
    for (;;) {
        const bool has_next = S.next(ui + 1, nxt);
        const char* nA = has_next ? nxt.A : cA; const char* nB = has_next ? nxt.B : cB;
        for (int t = 0; t < nt; t += 2) {
            const bool last = (t == nt - 2);
            const char* a1 = cA + (size_t)(t + 1) * kstep;
            const char* a2 = last ? nA : cA + (size_t)(t + 2) * kstep; const char* b2 = last ? nB : cB + (size_t)(t + 2) * kstep;
            const char* a3 = a2 + kstep; const char* b3 = b2 + kstep;
            PG8_LDB(B0, 0, 0); PG8_LDB(B1, 0, 1); PG8_SCHED; PG8_LDA(At, 0, 0); PG8_STAGE(PG8_SA(1, 1), a1 + hstep, voffA);
            PG8_WAIT_V(8); PG8_WAIT_L(0); PG8_BAR; PG8_MMA(0, 0, At, B0); PG8_MMA(0, 1, At, B1); PG8_BAR; PG8_SCHED;
            PG8_LDA(At, 0, 1); PG8_STAGE(PG8_SB(0, 0), b2, voffB); PG8_STAGE(PG8_SB(0, 1), b2 + hstep, voffB); PG8_STAGE(PG8_SA(0, 0), a2, voffA);
            PG8_WAIT_V(8); PG8_WAIT_L(0); PG8_BAR; PG8_MMA(1, 0, At, B0); PG8_MMA(1, 1, At, B1); PG8_BAR; PG8_SCHED;
            PG8_LDB(B0, 1, 0); PG8_LDB(B1, 1, 1); PG8_SCHED; PG8_LDA(At, 1, 0); PG8_STAGE(PG8_SA(0, 1), a2 + hstep, voffA);
            PG8_WAIT_V(8); PG8_WAIT_L(0); PG8_BAR; PG8_MMA(0, 0, At, B0); PG8_MMA(0, 1, At, B1); PG8_BAR; PG8_SCHED;
            PG8_LDA(At, 1, 1); PG8_STAGE(PG8_SB(1, 0), b3, voffB); PG8_STAGE(PG8_SB(1, 1), b3 + hstep, voffB); PG8_STAGE(PG8_SA(1, 0), a3, voffA);
            PG8_WAIT_V(8); PG8_WAIT_L(0); PG8_BAR; PG8_MMA(1, 0, At, B0); PG8_MMA(1, 1, At, B1); PG8_BAR; PG8_SCHED;
        }
        if (wr == 0) PG8_BAR;
        const bool keep = E(acc, cur, wr, wc, fr, fq);
        if (!has_next) break;
        if (!keep) {
#pragma unroll
            for (int a = 0; a < 2; ++a)
#pragma unroll
                for (int b = 0; b < 2; ++b)
#pragma unroll
                    for (int m = 0; m < 4; ++m)
#pragma unroll
                        for (int n = 0; n < 2; ++n) acc[a][b][m][n] = (f32x4){0.f, 0.f, 0.f, 0.f};
        }
        cur = nxt; cA = nA; cB = nB; ++ui;
        if (wr == 1) PG8_BAR;
    }
    PG8_WAIT_V(0);
    PG8_BAR;
#undef PG8_SA
#undef PG8_SB
#undef PG8_STAGE
#undef PG8_LDA
#undef PG8_LDB
#undef PG8_MMA
#undef PG8_WAIT_V
#undef PG8_WAIT_L
#undef PG8_BAR
#undef PG8_SCHED
}

struct EpiP1 {
    static constexpr bool PERM = true;
    const float* biasP; unsigned char* ws;
    __device__ __forceinline__ bool operator()(f32x4 (&acc)[2][2][4][2], const Unit& u, int wr, int wc, int fr, int fq) const {
        const int tile = u.pn;
        const int row0 = u.pm * BM + wr * 64 + fr, qc = wc * 32 + 8 * fq;
        f32x4 bv[2][2];
#pragma unroll
        for (int bj = 0; bj < 2; ++bj)
#pragma unroll
            for (int n = 0; n < 2; ++n) bv[bj][n] = *(const f32x4*)(biasP + tile * 256 + bj * HALF + qc + 4 * n);
        if (tile < 16) {
            bf16_t* O = (bf16_t*)(ws + (tile < 8 ? WS_H : WS_UB)) + (tile & 7) * 128 + qc;
            const bool glu = tile < 8;
#pragma unroll
            for (int ai = 0; ai < 2; ++ai)
#pragma unroll
                for (int m = 0; m < 4; ++m) {
                    bf16_t* rowp = O + (size_t)(row0 + ai * HALF + m * 16) * DM;
                    float o[8];
#pragma unroll
                    for (int n = 0; n < 2; ++n) { const f32x4 a = acc[ai][0][m][n] + bv[0][n], g = acc[ai][1][m][n] + bv[1][n];
#pragma unroll
                        for (int j = 0; j < 4; ++j) o[4 * n + j] = glu ? a[j] * fsigmoid(g[j]) : fgelu(a[j]) * fsilu(g[j]); }
                    u32x4 w; w.x = pk2(o[0], o[1]); w.y = pk2(o[2], o[3]); w.z = pk2(o[4], o[5]); w.w = pk2(o[6], o[7]);
                    *(u32x4*)rowp = w;
                }
        } else {
            const int kind = (tile - 16) >> 2;
            size_t ooff = (size_t)(192 + 64 * kind) * MiB; if (kind == 0) ooff = WS_SA;
            bf16_t* O = (bf16_t*)(ws + ooff) + (tile & 3) * 256 + qc;
#pragma unroll
            for (int ai = 0; ai < 2; ++ai)
#pragma unroll
                for (int m = 0; m < 4; ++m) {
                    bf16_t* rowp = O + (size_t)(row0 + ai * HALF + m * 16) * DM;
#pragma unroll
                    for (int bj = 0; bj < 2; ++bj) {
                        float o[8];
#pragma unroll
                        for (int n = 0; n < 2; ++n) { const f32x4 a = acc[ai][bj][m][n] + bv[bj][n];
#pragma unroll
                            for (int j = 0; j < 4; ++j) o[4 * n + j] = kind == 0 ? fsilu(a[j]) : kind == 1 ? fgelu(a[j]) : fsigmoid(a[j]); }
                        u32x4 w; w.x = pk2(o[0], o[1]); w.y = pk2(o[2], o[3]); w.z = pk2(o[4], o[5]); w.w = pk2(o[6], o[7]);
                        *(u32x4*)(rowp + bj * HALF) = w;
                    }
                }
        }
        return false;
    }
};

struct EpiP3 {
    static constexpr bool PERM = true;
    const bf16_t *GA, *GB; bf16_t* MIX;
    __device__ __forceinline__ bool operator()(f32x4 (&acc)[2][2][4][2], const Unit& u, int wr, int wc, int fr, int fq) const {
        const int row0 = u.pm * BM + wr * 64 + fr, col0 = u.pn * BM + wc * 32 + 8 * fq;
        const bool first = (u.kind == 0);
#pragma unroll
        for (int ai = 0; ai < 2; ++ai)
#pragma unroll
            for (int m = 0; m < 4; ++m) {
                const size_t ro = (size_t)(row0 + ai * HALF + m * 16) * DM + col0;
#pragma unroll
                for (int bj = 0; bj < 2; ++bj) {
                    const u32x4 gb = *(const u32x4*)(GB + ro + bj * HALF);
                    float b[8] = {bf_lo(gb.x), bf_hi(gb.x), bf_lo(gb.y), bf_hi(gb.y), bf_lo(gb.z), bf_hi(gb.z), bf_lo(gb.w), bf_hi(gb.w)};
                    if (first) {
                        const u32x4 ga = *(const u32x4*)(GA + ro + bj * HALF);
                        float a[8] = {bf_lo(ga.x), bf_hi(ga.x), bf_lo(ga.y), bf_hi(ga.y), bf_lo(ga.z), bf_hi(ga.z), bf_lo(ga.w), bf_hi(ga.w)};
#pragma unroll
                        for (int n = 0; n < 2; ++n)
#pragma unroll
                            for (int j = 0; j < 4; ++j) acc[ai][bj][m][n][j] *= a[4 * n + j] * __builtin_amdgcn_rcpf(b[4 * n + j]);
                    } else {
                        float o[8];
#pragma unroll
                        for (int n = 0; n < 2; ++n)
#pragma unroll
                            for (int j = 0; j < 4; ++j) o[4 * n + j] = acc[ai][bj][m][n][j] * b[4 * n + j];
                        u32x4 w; w.x = pk2(o[0], o[1]); w.y = pk2(o[2], o[3]); w.z = pk2(o[4], o[5]); w.w = pk2(o[6], o[7]);
                        *(u32x4*)(MIX + ro + bj * HALF) = w;
                    }
                }
            }
        return first;
    }
};

struct EpiP4 {
    static constexpr bool PERM = false;
    const float *x, *bo; float* out; float* stat;
    __device__ __forceinline__ bool operator()(f32x4 (&acc)[2][2][4][2], const Unit& u, int wr, int wc, int fr, int fq) const {
        const int row0 = u.pm * BM + wr * 64 + fr, col0 = u.pn * BM + wc * 32 + 4 * fq;
        f32x4 bv[2][2];
#pragma unroll
        for (int bj = 0; bj < 2; ++bj)
#pragma unroll
            for (int n = 0; n < 2; ++n) bv[bj][n] = *(const f32x4*)(bo + col0 + bj * HALF + n * 16);
#pragma unroll
        for (int ai = 0; ai < 2; ++ai)
#pragma unroll
            for (int m = 0; m < 4; ++m) {
                const int row = row0 + ai * HALF + m * 16;
                const size_t ro = (size_t)row * DM + col0;
                float s1 = 0.f, s2 = 0.f;
#pragma unroll
                for (int bj = 0; bj < 2; ++bj)
#pragma unroll
                    for (int n = 0; n < 2; ++n) {
                        const f32x4 xv = *(const f32x4*)(x + ro + bj * HALF + n * 16);
                        const f32x4 y = acc[ai][bj][m][n] + bv[bj][n] + ALPHA * xv;
                        *(f32x4*)(out + ro + bj * HALF + n * 16) = y;
                        s1 += (y[0] + y[1]) + (y[2] + y[3]); s2 += (y[0] * y[0] + y[1] * y[1]) + (y[2] * y[2] + y[3] * y[3]);
                    }
                s1 += __shfl_xor(s1, 16); s1 += __shfl_xor(s1, 32); s2 += __shfl_xor(s2, 16); s2 += __shfl_xor(s2, 32);
                if (fq == 0) { __hip_atomic_fetch_add(stat + 2 * row, s1, __ATOMIC_RELAXED, __HIP_MEMORY_SCOPE_AGENT); __hip_atomic_fetch_add(stat + 2 * row + 1, s2, __ATOMIC_RELAXED, __HIP_MEMORY_SCOPE_AGENT); }
            }
        return false;
    }
};

template <bool PERMUTE>
__device__ __forceinline__ void p0_transpose_item(const float* W, int K, int N, bf16_t* WT, LAS float* scr, int item, int lane) {
    const int nblk = N / 32, kb = item / nblk, nb = item % nblk, k0 = 64 * kb, n0 = 32 * nb;
    const int src0 = PERMUTE ? orig_col(n0) : n0;
#pragma unroll 8
    for (int i = 0; i < 32; ++i) { const int kk = 2 * i + (lane >> 5); scr[kk * 33 + (lane & 31)] = W[(size_t)(k0 + kk) * N + src0 + (lane & 31)]; }
    asm volatile("s_waitcnt lgkmcnt(0)" ::: "memory");
    const int c = lane & 7;
#pragma unroll
    for (int j = 0; j < 4; ++j) { const int n = (lane >> 3) + 8 * j; const LAS float* s = scr + (8 * c) * 33 + n;
        u32x4 o; o.x = pk2(s[0 * 33], s[1 * 33]); o.y = pk2(s[2 * 33], s[3 * 33]); o.z = pk2(s[4 * 33], s[5 * 33]); o.w = pk2(s[6 * 33], s[7 * 33]);
        *(u32x4*)(WT + (size_t)(n0 + n) * K + k0 + 8 * c) = o; }
    asm volatile("s_waitcnt lgkmcnt(0)" ::: "memory");
}

__device__ __forceinline__ void p0_prologue(const Args& a, LAS unsigned char* lds, int tid, int wave, int lane) {
    unsigned char* ws = a.ws;
    const size_t gt = (size_t)blockIdx.x * 512 + tid, GT = (size_t)gridDim.x * 512;
    LAS float* scr = (LAS float*)(lds + wave * 16384);
    const int gw = blockIdx.x * 8 + wave, NGW = gridDim.x * 8;
    constexpr int I_IN = (DM / 64) * (DIN / 32), I_SQ = (DM / 64) * (DM / 32);
    for (int it = gw; it < I_IN + 3 * I_SQ; it += NGW) {
        int r = it;
        if (r < I_IN) { p0_transpose_item<true>(a.in[1], DM, DIN, (bf16_t*)(ws + WS_WIN), scr, r, lane); continue; } r -= I_IN;
        if (r < I_SQ) { p0_transpose_item<false>(a.in[11], DM, DM, (bf16_t*)(ws + WS_WPA), scr, r, lane); continue; } r -= I_SQ;
        if (r < I_SQ) { p0_transpose_item<false>(a.in[12], DM, DM, (bf16_t*)(ws + WS_WPB), scr, r, lane); continue; } r -= I_SQ;
        p0_transpose_item<false>(a.in[13], DM, DM, (bf16_t*)(ws + WS_WO), scr, r, lane);
    }
    if (gt < 8 * 128 * 128) { const int t = (int)(gt >> 7) & 127, s = (int)gt & 127; const float w = a.in[9][gt]; ((bf16_t*)(ws + WS_WS))[gt] = (s <= t) ? (bf16_t)(pk2(w, 0.f) & 0xffffu) : (bf16_t)0; }
    if (gt < DIN) ((float*)(ws + WS_BIAS))[gt] = a.in[2][orig_col((int)gt)];
    if (gt < 2 * NTOK) ((float*)(ws + WS_STAT))[gt] = 0.f;
    const f32x4* x4 = (const f32x4*)a.in[0]; u32x4* xb = (u32x4*)(ws + WS_XB);
    for (size_t i = gt; i < (size_t)NTOK * DM / 8; i += GT) {
        const f32x4 p = x4[2 * i], q = x4[2 * i + 1];
        u32x4 o; o.x = pk2(p[0], p[1]); o.y = pk2(p[2], p[3]); o.z = pk2(q[0], q[1]); o.w = pk2(q[2], q[3]);
        xb[i] = o;
    }
}

__device__ __forceinline__ void p2_conv(const Args& a, int chunk, int wave, int lane) {
    const bf16_t* H = (const bf16_t*)(a.ws + WS_H); bf16_t* SA = (bf16_t*)(a.ws + WS_SA);
    const float *conv_w = a.in[3], *conv_b = a.in[4], *gn_g = a.in[5], *gn_b = a.in[6];
    const bool has_prev = (chunk & 15) != 0;
    const long R0 = (long)chunk * 128;
    const int t0 = wave * 16;
    for (int g = 0; g < 8; ++g) {
        const int c = g * 128 + 2 * lane;
        f32x2 w[31];
#pragma unroll
        for (int j = 0; j < 31; ++j) w[j] = *(const f32x2*)(conv_w + j * DM + c);
        const f32x2 cb = *(const f32x2*)(conv_b + c);
        f32x2 acc[16];
#pragma unroll
        for (int t = 0; t < 16; ++t) acc[t] = cb;
#pragma unroll
        for (int idx = 0; idx < 46; ++idx) {
            const int tok = t0 - 30 + idx;
            unsigned raw = 0u;
            if (tok >= 0 || has_prev) raw = *(const unsigned*)(H + (R0 + tok) * DM + c);
            const f32x2 hv = {bf_lo(raw), bf_hi(raw)};
#pragma unroll
            for (int t = 0; t < 16; ++t) { const int j = idx - t; if (j >= 0 && j <= 30) acc[t] += w[j] * hv; }
        }
        const f32x2 gg = *(const f32x2*)(gn_g + c), gb = *(const f32x2*)(gn_b + c);
#pragma unroll
        for (int t = 0; t < 16; ++t) {
            const float s1 = wave_sum(acc[t].x + acc[t].y), s2 = wave_sum(acc[t].x * acc[t].x + acc[t].y * acc[t].y);
            const float mean = s1 * (1.f / 128.f), var = fmaxf(s2 * (1.f / 128.f) - mean * mean, 0.f), rstd = __builtin_amdgcn_rsqf(var + LN_EPS);
            const float y0 = (acc[t].x - mean) * rstd * gg.x + gb.x, y1 = (acc[t].y - mean) * rstd * gg.y + gb.y;
            unsigned* p = (unsigned*)(SA + (R0 + t0 + t) * DM + c);
            const unsigned sraw = *p;
            *p = pk2(fsilu(y0) * bf_lo(sraw), fsilu(y1) * bf_hi(sraw));
        }
    }
}

__device__ __forceinline__ void p2_gmlp(const Args& a, LAS unsigned char* lds, int chunk, int tid, int wave, int lane) {
    const bf16_t* V = (const bf16_t*)(a.ws + WS_V); bf16_t* UB = (bf16_t*)(a.ws + WS_UB); const bf16_t* WsB = (const bf16_t*)(a.ws + WS_WS);
    const float *ln_g = a.in[7], *ln_b = a.in[8], *b_sp = a.in[10];
    LAS float* mu = (LAS float*)lds; LAS float* rs = mu + 128;
    LAS unsigned char* vt = lds + 1024;
    const long R0 = (long)chunk * 128;
    const int t0 = wave * 16;
#pragma unroll 1
    for (int tt = 0; tt < 16; tt += 4) {
        u32x4 r[4][2];
#pragma unroll
        for (int q = 0; q < 4; ++q) { const bf16_t* row = V + (R0 + t0 + tt + q) * DM; r[q][0] = *(const u32x4*)(row + lane * 8); r[q][1] = *(const u32x4*)(row + 512 + lane * 8); }
#pragma unroll
        for (int q = 0; q < 4; ++q) {
            float s1 = 0.f, s2 = 0.f;
#pragma unroll
            for (int k = 0; k < 2; ++k)
#pragma unroll
                for (int e = 0; e < 4; ++e) { const float lo = bf_lo(r[q][k][e]), hi = bf_hi(r[q][k][e]); s1 += lo + hi; s2 += lo * lo + hi * hi; }
            s1 = wave_sum(s1); s2 = wave_sum(s2);
            const float mean = s1 * (1.f / 1024.f), var = fmaxf(s2 * (1.f / 1024.f) - mean * mean, 0.f);
            if (lane == 0) { mu[t0 + tt + q] = mean; rs[t0 + tt + q] = __builtin_amdgcn_rsqf(var + LN_EPS); }
        }
    }
    __syncthreads();
    const int d = tid & 127, sgq = tid >> 7;
    const int wt = wave >> 1, wd = wave & 1, fr = lane & 15, fq = lane >> 4;
#pragma unroll 1
    for (int h = 0; h < 8; ++h) {
        LAS unsigned char* buf = vt + (h & 1) * 32768;
        const float g = ln_g[h * 128 + d], be = ln_b[h * 128 + d];
#pragma unroll
        for (int i = 0; i < 4; ++i) {
            const int sg = sgq * 4 + i;
            const bf16_t* src = V + (R0 + sg * 8) * DM + h * 128 + d;
            unsigned raw[8];
#pragma unroll
            for (int e = 0; e < 8; ++e) raw[e] = src[(size_t)e * DM];
            float v[8];
#pragma unroll
            for (int e = 0; e < 8; ++e) v[e] = (__uint_as_float(raw[e] << 16) - mu[sg * 8 + e]) * rs[sg * 8 + e] * g + be;
            u32x4 o; o.x = pk2(v[0], v[1]); o.y = pk2(v[2], v[3]); o.z = pk2(v[4], v[5]); o.w = pk2(v[6], v[7]);
            *(LAS u32x4*)(buf + d * 256 + ((sg + d) & 15) * 16) = o;
        }
        __syncthreads();
        f32x4 acc[2][4];
#pragma unroll
        for (int mi = 0; mi < 2; ++mi)
#pragma unroll
            for (int ni = 0; ni < 4; ++ni) acc[mi][ni] = (f32x4){0.f, 0.f, 0.f, 0.f};
        for (int ks = 0; ks <= wt; ++ks) {
            bf16x8 wf[2], vf[4];
#pragma unroll
            for (int mi = 0; mi < 2; ++mi) wf[mi] = *(const bf16x8*)(WsB + (size_t)((h * 128 + 32 * wt + 16 * mi + fr) * 128 + ks * 32 + fq * 8));
#pragma unroll
            for (int ni = 0; ni < 4; ++ni) { const int dd = 64 * wd + 16 * ni + fr; vf[ni] = *(const LAS bf16x8*)(buf + dd * 256 + (((ks * 4 + fq) + dd) & 15) * 16); }
#pragma unroll
            for (int mi = 0; mi < 2; ++mi)
#pragma unroll
                for (int ni = 0; ni < 4; ++ni) acc[mi][ni] = __builtin_amdgcn_mfma_f32_16x16x32_bf16(vf[ni], wf[mi], acc[mi][ni], 0, 0, 0);
        }
#pragma unroll
        for (int mi = 0; mi < 2; ++mi) {
            const int t = 32 * wt + 16 * mi + fr;
            const float bsp = b_sp[h * 128 + t];
#pragma unroll
            for (int ni = 0; ni < 4; ++ni) {
                u32x2* p = (u32x2*)(UB + (R0 + t) * DM + h * 128 + 64 * wd + 16 * ni + 4 * fq);
                const u32x2 ub = *p;
                u32x2 o; o.x = pk2((acc[mi][ni][0] + bsp) * bf_lo(ub.x), (acc[mi][ni][1] + bsp) * bf_hi(ub.x));
                o.y = pk2((acc[mi][ni][2] + bsp) * bf_lo(ub.y), (acc[mi][ni][3] + bsp) * bf_hi(ub.y));
                *p = o;
            }
        }
    }
    __syncthreads();
}

__device__ __forceinline__ void p5_ln(const Args& a, int wave, int lane) {
    const float* stat = (const float*)(a.ws + WS_STAT);
    const f32x4* g4 = (const f32x4*)a.in[15]; const f32x4* b4 = (const f32x4*)a.in[16];
    f32x4 gg[4], bb[4];
#pragma unroll
    for (int j = 0; j < 4; ++j) { gg[j] = g4[lane + 64 * j]; bb[j] = b4[lane + 64 * j]; }
    for (int row = blockIdx.x * 8 + wave; row < NTOK; row += gridDim.x * 8) {
        const float s1 = stat[2 * row], s2 = stat[2 * row + 1];
        const float mean = s1 * (1.f / 1024.f), var = fmaxf(s2 * (1.f / 1024.f) - mean * mean, 0.f), rstd = __builtin_amdgcn_rsqf(var + LN_EPS);
        f32x4* p = (f32x4*)(a.out + (size_t)row * DM) + lane;
        f32x4 v[4];
#pragma unroll
        for (int j = 0; j < 4; ++j) v[j] = p[64 * j];
#pragma unroll
        for (int j = 0; j < 4; ++j) p[64 * j] = (v[j] - mean) * rstd * gg[j] + bb[j];
    }
}

__global__ void __launch_bounds__(512) fwd_megakernel(Args a) {
    extern __shared__ __attribute__((aligned(16))) unsigned char lds_raw[];
    LAS unsigned char* lds = (LAS unsigned char*)lds_raw;
    cg::grid_group grid = cg::this_grid();
    const int tid = threadIdx.x, lane = tid & 63, wave = __builtin_amdgcn_readfirstlane(tid >> 6);
    const int G = gridDim.x, c = blockIdx.x;
    unsigned char* ws = a.ws;
    const int lo = a.ph_lo, hi = a.ph_hi;
#define IN(k) (lo <= (k) && (k) < hi)
#define SEAM(k) do { if (IN(k) && IN((k) + 1)) grid.sync(); } while (0)

    if (IN(0)) { p0_prologue(a, lds, tid, wave, lane); }
    SEAM(0);
    if (IN(1)) {
        SchedSimple S{(const char*)(ws + WS_XB), (const char*)(ws + WS_WIN), NTOK / BM, DIN / BM, G, c};
        EpiP1 E{(const float*)(ws + WS_BIAS), ws};
        gemm_phase(lds, S, E);
    }
    SEAM(1);
    if (IN(2)) {
        for (int chunk = c; chunk < NTOK / 128; chunk += G) { p2_gmlp(a, lds, chunk, tid, wave, lane); p2_conv(a, chunk, wave, lane); }
    }
    SEAM(2);
    if (IN(3)) {
        SchedDual S{(const char*)(ws + WS_SA), (const char*)(ws + WS_WPA), (const char*)(ws + WS_UB), (const char*)(ws + WS_WPB), NTOK / BM, DM / BM, G, c};
        EpiP3 E{(const bf16_t*)(ws + WS_GA), (const bf16_t*)(ws + WS_GB), (bf16_t*)(ws + WS_MIX)};
        gemm_phase(lds, S, E);
    }
    SEAM(3);
    if (IN(4)) {
        SchedSimple S{(const char*)(ws + WS_MIX), (const char*)(ws + WS_WO), NTOK / BM, DM / BM, G, c};
        EpiP4 E{a.in[0], a.in[14], a.out, (float*)(ws + WS_STAT)};
        gemm_phase(lds, S, E);
    }
    SEAM(4);
    if (IN(5)) { p5_ln(a, wave, lane); }
}

extern "C" void kernel_launch(void* const* d_in, const int* in_sizes, int n_in, void* d_out, int out_size, void* d_ws, size_t ws_size, hipStream_t stream) {
    static int grid = 0;
    if (grid == 0) {
        if (n_in != 17 || in_sizes[0] != NTOK * DM || out_size != NTOK * DM || ws_size < WS_END) {
            fprintf(stderr, "kernel_launch: unexpected shapes (n_in %d, in0 %d, out %d, ws %zu < %zu); nothing launched\n", n_in, n_in > 0 ? in_sizes[0] : -1, out_size, ws_size, (size_t)WS_END); grid = -1; return; }
        int dev = 0, cus = 0, per_cu = 0;
        (void)hipGetDevice(&dev);
        (void)hipDeviceGetAttribute(&cus, hipDeviceAttributeMultiprocessorCount, dev);
        if (hipFuncSetAttribute((const void*)fwd_megakernel, hipFuncAttributeMaxDynamicSharedMemorySize, LDS_BYTES) != hipSuccess) { fprintf(stderr, "kernel_launch: hipFuncSetAttribute failed\n"); grid = -1; return; }
        if (hipOccupancyMaxActiveBlocksPerMultiprocessor(&per_cu, (const void*)fwd_megakernel, 512, LDS_BYTES) != hipSuccess || per_cu < 1) { fprintf(stderr, "kernel_launch: occupancy query failed (%d)\n", per_cu); (void)hipGetLastError(); per_cu = 1; }
        if (per_cu > 1) per_cu = 1;
        grid = cus * per_cu;
    }
    if (grid < 0) return;
    Args a{};
    for (int i = 0; i < 17; ++i) a.in[i] = (const float*)d_in[i];
    a.out = (float*)d_out; a.ws = (unsigned char*)d_ws;
#if N_LAUNCHES == 1
    a.ph_lo = 0; a.ph_hi = 6;
    void* args[] = {&a};
    hipError_t e = hipLaunchCooperativeKernel((const void*)fwd_megakernel, dim3(grid), dim3(512), args, LDS_BYTES, stream);
    if (e != hipSuccess) fprintf(stderr, "cooperative launch failed: %s (grid %d)\n", hipGetErrorString(e), grid);
#else
    for (int ph = 0; ph < 6; ++ph) {
        a.ph_lo = ph; a.ph_hi = ph + 1;
        hipLaunchKernelGGL(fwd_megakernel, dim3(grid), dim3(512), LDS_BYTES, stream, a);
    }
#endif
}
```

```cpp
#include <hip/hip_runtime.h>
#include <hip/hip_cooperative_groups.h>
#include <cstdio>
#include <cstdint>
namespace cg = cooperative_groups;

#ifndef N_LAUNCHES
#define N_LAUNCHES 1
#endif

#define LAS __attribute__((address_space(3)))
typedef unsigned short bf16_t;
typedef short bf16x8 __attribute__((ext_vector_type(8)));
typedef float f32x4 __attribute__((ext_vector_type(4)));
typedef float f32x2 __attribute__((ext_vector_type(2)));
typedef unsigned u32x4 __attribute__((ext_vector_type(4)));
typedef unsigned u32x2 __attribute__((ext_vector_type(2)));

constexpr int DM = 1024, NTOK = 32768, DIN = 8192;
constexpr float LN_EPS = 1e-5f;
constexpr float ALPHA = 1.189207115002721f;
constexpr int BM = 256, BK = 64, HALF = 128, HTB = HALF * BK * 2, STAGE_BYTES = 8 * HTB, WGM = 8;
constexpr int LDS_BYTES = STAGE_BYTES;
constexpr int KDIM = 1024;

constexpr size_t MiB = (size_t)1 << 20;
constexpr size_t WS_XB = 0, WS_H = 64 * MiB, WS_SA = 128 * MiB, WS_UB = 192 * MiB, WS_V = 256 * MiB, WS_GA = 320 * MiB, WS_GB = 384 * MiB;
constexpr size_t WS_WIN = 448 * MiB, WS_WPA = 464 * MiB, WS_WPB = 466 * MiB, WS_WO = 468 * MiB, WS_WS = 470 * MiB;
constexpr size_t WS_BIAS = WS_WS + 256 * 1024, WS_STAT = WS_BIAS + 256 * 1024, WS_END = 471 * MiB;
constexpr size_t WS_MIX = WS_XB;

struct Args {
    const float* in[17];
    float* out;
    unsigned char* ws;
    int ph_lo, ph_hi;
};

typedef __bf16 bf16x2_t __attribute__((ext_vector_type(2)));
__device__ __forceinline__ unsigned pk2(float lo, float hi) { const f32x2 v = {lo, hi}; return __builtin_bit_cast(unsigned, __builtin_convertvector(v, bf16x2_t)); }
__device__ __forceinline__ float bf_lo(unsigned u) { return __uint_as_float(u << 16); }
__device__ __forceinline__ float bf_hi(unsigned u) { return __uint_as_float(u & 0xffff0000u); }
#ifdef PROBE_NOACT
__device__ __forceinline__ float fsigmoid(float x) { return 0.5f + 0.01f * x; }
__device__ __forceinline__ float fsigmoid_unused(float x) {
#else
__device__ __forceinline__ float fsigmoid(float x) {
#endif
    return __builtin_amdgcn_rcpf(1.0f + __builtin_amdgcn_exp2f(-1.4426950408889634f * x)); }
__device__ __forceinline__ float fsilu(float x) { return x * fsigmoid(x); }
__device__ __forceinline__ float fgelu(float x) { return x * fsigmoid(1.5957691216057308f * (x + 0.044715f * x * x * x)); }
__device__ __forceinline__ float wave_sum(float v) {
#pragma unroll
    for (int o = 1; o < 64; o <<= 1) v += __shfl_xor(v, o);
    return v;
}
__host__ __device__ __forceinline__ int orig_col(int p) {
    const int tile = p >> 8, q = p & 255;
    if (tile < 8) return (q < 128) ? tile * 128 + q : 1024 + tile * 128 + (q - 128);
    if (tile < 16) { const int tt = tile - 8; return (q < 128) ? 3072 + tt * 128 + q : 5120 + tt * 128 + (q - 128); }
    if (tile < 20) return 2048 + (tile - 16) * 256 + q;
    if (tile < 24) return 4096 + (tile - 20) * 256 + q;
    if (tile < 28) return 6144 + (tile - 24) * 256 + q;
    return 7168 + (tile - 28) * 256 + q;
}

__host__ __device__ __forceinline__ int lds_byte(int r, int c) { const int st = (r >> 4) * 2 + (c >> 5), rr = r & 15, cc = c & 31, ob = rr * 64 + cc * 2; return st * 1024 + (ob ^ (((ob >> 9) & 1) << 5)); }
__host__ __device__ __forceinline__ void stage_rc(int b, int& R, int& C) { const int st = b / 1024, sb = b % 1024, swz = sb ^ (((sb >> 9) & 1) << 5); R = (st >> 1) * 16 + swz / 64; C = (st & 1) * 32 + (swz % 64) / 2; }
__host__ __device__ __forceinline__ int perm32(int rho) { const int n = rho >> 4, i = rho & 15; return 8 * (i >> 2) + 4 * n + (i & 3); }

struct Unit { const char* A; const char* B; int pm, pn, kind; };

__device__ __forceinline__ bool tile_order(long L, int nM, int nN, int& pm, int& pn) {
    const int nwg = nM * nN; if (L >= nwg) return false;
    int wgid = (int)L; { const int q = nwg / 8, r = nwg % 8, xcd = wgid % 8, off = wgid / 8; wgid = (xcd < r ? xcd * (q + 1) : r * (q + 1) + (xcd - r) * q) + off; }
    const int nig = WGM * nN, gid = wgid / nig, fm = gid * WGM, gsz = (nM - fm) < WGM ? (nM - fm) : WGM;
    pm = fm + ((wgid % nig) % gsz); pn = (wgid % nig) / gsz; return true;
}
constexpr size_t TSTEP = (size_t)BM * KDIM * 2;

struct SchedSimple {
    const char* A; const char* B; int nM, nN, G, c;
    __device__ __forceinline__ bool next(int i, Unit& u) const {
        if (!tile_order((long)i * G + c, nM, nN, u.pm, u.pn)) return false;
        u.A = A + (size_t)u.pm * TSTEP; u.B = B + (size_t)u.pn * TSTEP; u.kind = 1; return true;
    }
};
struct SchedDual {
    const char *A0, *B0, *A1, *B1; int nM, nN, G, c;
    __device__ __forceinline__ bool next(int i, Unit& u) const {
        if (!tile_order((long)(i >> 1) * G + c, nM, nN, u.pm, u.pn)) return false;
        u.kind = i & 1;
        u.A = (u.kind ? A1 : A0) + (size_t)u.pm * TSTEP; u.B = (u.kind ? B1 : B0) + (size_t)u.pn * TSTEP; return true;
    }
};

template <class Epi, class Sched>
__device__ __forceinline__ void gemm_phase(LAS unsigned char* lds, const Sched& S, const Epi& E) {
    const int tid = threadIdx.x, wid = __builtin_amdgcn_readfirstlane(tid >> 6), lane = tid & 63, wr = wid >> 2, wc = wid & 3, fr = lane & 15, fq = lane >> 4;
    constexpr int K = KDIM, nt = K / BK;
    unsigned voffA[2], voffB[2];
#pragma unroll
    for (int i = 0; i < 2; ++i) { int R, C; stage_rc(tid * 16 + i * 8192, R, C); const int Rb = Epi::PERM ? ((R & ~31) + perm32(R & 31)) : R;
        voffA[i] = (unsigned)(R * K + C) * 2u; voffB[i] = (unsigned)(Rb * K + C) * 2u; }
    constexpr size_t kstep = (size_t)(BK * 2);
    constexpr size_t hstep = (size_t)HALF * K * 2;
    const unsigned ldsw = (unsigned)wid * 1024u;
    const int aoff = lds_byte(wr * 64 + fr, fq * 8), boff = lds_byte(wc * 32 + fr, fq * 8);
#define PG8_SA(b, h) (((b) * 2 + (h)) * HTB)
#define PG8_SB(b, h) ((4 + (b) * 2 + (h)) * HTB)
#define PG8_STAGE(bufoff, gbase, voff) do { _Pragma("unroll") for (int _i = 0; _i < 2; ++_i) \
        __builtin_amdgcn_global_load_lds((const unsigned*)((const char*)(gbase) + (voff)[_i]), (LAS unsigned*)(lds + (bufoff) + ldsw + _i * 8192), 16, 0, 0); } while (0)
#define PG8_LDA(dst, b, h) do { _Pragma("unroll") for (int m = 0; m < 4; ++m) _Pragma("unroll") for (int k = 0; k < 2; ++k) dst[m][k] = *(const LAS bf16x8*)(lds + PG8_SA(b, h) + aoff + m * 2048 + k * 1024); } while (0)
#define PG8_LDB(dst, b, h) do { _Pragma("unroll") for (int n = 0; n < 2; ++n) _Pragma("unroll") for (int k = 0; k < 2; ++k) dst[n][k] = *(const LAS bf16x8*)(lds + PG8_SB(b, h) + boff + n * 2048 + k * 1024); } while (0)
#define PG8_MMA(ai, bj, At, Bt) do { __builtin_amdgcn_s_setprio(1); _Pragma("unroll") for (int m = 0; m < 4; ++m) _Pragma("unroll") for (int n = 0; n < 2; ++n) _Pragma("unroll") for (int k = 0; k < 2; ++k) \
        acc[ai][bj][m][n] = __builtin_amdgcn_mfma_f32_16x16x32_bf16(Bt[n][k], At[m][k], acc[ai][bj][m][n], 0, 0, 0); __builtin_amdgcn_s_setprio(0); } while (0)
#define PG8_WAIT_V(n) asm volatile("s_waitcnt vmcnt(" #n ")" ::: "memory")
#define PG8_WAIT_L(n) asm volatile("s_waitcnt lgkmcnt(" #n ")" ::: "memory")
#define PG8_BAR __builtin_amdgcn_s_barrier()
#define PG8_SCHED __builtin_amdgcn_sched_barrier(0)
    Unit cur, nxt; int ui = 0;
    if (!S.next(0, cur)) return;
    f32x4 acc[2][2][4][2];
#pragma unroll
    for (int a = 0; a < 2; ++a)
#pragma unroll
        for (int b = 0; b < 2; ++b)
#pragma unroll
            for (int m = 0; m < 4; ++m)
#pragma unroll
                for (int n = 0; n < 2; ++n) acc[a][b][m][n] = (f32x4){0.f, 0.f, 0.f, 0.f};
    bf16x8 At[4][2], B0[2][2], B1[2][2];
    const char* cA = cur.A; const char* cB = cur.B;
    PG8_STAGE(PG8_SB(0, 0), cB, voffB); PG8_STAGE(PG8_SB(0, 1), cB + hstep, voffB); PG8_STAGE(PG8_SA(0, 0), cA, voffA); PG8_STAGE(PG8_SA(0, 1), cA + hstep, voffA);
    if (wr == 1) PG8_BAR;
    PG8_WAIT_V(2); PG8_BAR;
    PG8_STAGE(PG8_SB(1, 0), cB + kstep, voffB); PG8_STAGE(PG8_SA(1, 0), cA + kstep, voffA); PG8_STAGE(PG8_SB(1, 1), cB + hstep + kstep, voffB);
    PG8_WAIT_V(6); PG8_BAR;
    for (;;) {
        const bool has_next = S.next(ui + 1, nxt);
        const char* nA = has_next ? nxt.A : cA; const char* nB = has_next ? nxt.B : cB;
        for (int t = 0; t < nt; t += 2) {
            const bool last = (t == nt - 2);
            const char* a1 = cA + (size_t)(t + 1) * kstep;
            const char* a2 = last ? nA : cA + (size_t)(t + 2) * kstep; const char* b2 = last ? nB : cB + (size_t)(t + 2) * kstep;
            const char* a3 = a2 + kstep; const char* b3 = b2 + kstep;
            PG8_LDB(B0, 0, 0); PG8_LDB(B1, 0, 1); PG8_SCHED; PG8_LDA(At, 0, 0); PG8_STAGE(PG8_SA(1, 1), a1 + hstep, voffA);
            PG8_WAIT_V(8); PG8_WAIT_L(0); PG8_BAR; PG8_MMA(0, 0, At, B0); PG8_MMA(0, 1, At, B1); PG8_BAR; PG8_SCHED;
            PG8_LDA(At, 0, 1); PG8_STAGE(PG8_SB(0, 0), b2, voffB); PG8_STAGE(PG8_SB(0, 1), b2 + hstep, voffB); PG8_STAGE(PG8_SA(0, 0), a2, voffA);
            PG8_WAIT_V(8); PG8_WAIT_L(0); PG8_BAR; PG8_MMA(1, 0, At, B0); PG8_MMA(1, 1, At, B1); PG8_BAR; PG8_SCHED;
            PG8_LDB(B0, 1, 0); PG8_LDB(B1, 1, 1); PG8_SCHED; PG8_LDA(At, 1, 0); PG8_STAGE(PG8_SA(0, 1), a2 + hstep, voffA);
            PG8_WAIT_V(8); PG8_WAIT_L(0); PG8_BAR; PG8_MMA(0, 0, At, B0); PG8_MMA(0, 1, At, B1); PG8_BAR; PG8_SCHED;
            PG8_LDA(At, 1, 1); PG8_STAGE(PG8_SB(1, 0), b3, voffB); PG8_STAGE(PG8_SB(1, 1), b3 + hstep, voffB); PG8_STAGE(PG8_SA(1, 0), a3, voffA);
            PG8_WAIT_V(8); PG8_WAIT_L(0); PG8_BAR; PG8_MMA(1, 0, At, B0); PG8_MMA(1, 1, At, B1); PG8_BAR; PG8_SCHED;
        }
        if (wr == 0) PG8_BAR;
#ifdef PROBE_EPI2X
        if (Epi::TWICE) { E(acc, cur, wr, wc, fr, fq);
            _Pragma("unroll") for (int a = 0; a < 2; ++a) _Pragma("unroll") for (int b = 0; b < 2; ++b) _Pragma("unroll") for (int m = 0; m < 4; ++m) _Pragma("unroll") for (int n = 0; n < 2; ++n) asm volatile("" : "+v"(acc[a][b][m][n]) :: "memory"); }
#endif
        const bool keep = E(acc, cur, wr, wc, fr, fq);
        if (!has_next) break;
        if (!keep) {
#pragma unroll
            for (int a = 0; a < 2; ++a)
#pragma unroll
                for (int b = 0; b < 2; ++b)
#pragma unroll
                    for (int m = 0; m < 4; ++m)
#pragma unroll
                        for (int n = 0; n < 2; ++n) acc[a][b][m][n] = (f32x4){0.f, 0.f, 0.f, 0.f};
        }
        cur = nxt; cA = nA; cB = nB; ++ui;
        if (wr == 1) PG8_BAR;
    }
    PG8_WAIT_V(0);
    PG8_BAR;
#undef PG8_SA
#undef PG8_SB
#undef PG8_STAGE
#undef PG8_LDA
#undef PG8_LDB
#undef PG8_MMA
#undef PG8_WAIT_V
#undef PG8_WAIT_L
#undef PG8_BAR
#undef PG8_SCHED
}

template <int T> __device__ __forceinline__ float act1(float a) { return T == 0 ? fsilu(a) : T == 1 ? fgelu(a) : fsigmoid(a); }
template <int T  > __device__ __forceinline__ void epi_pair(const f32x4 (&acc)[2][2][4][2], const f32x4 (&bv)[2][2], bf16_t* O, int row0) {
#pragma unroll
    for (int ai = 0; ai < 2; ++ai)
#pragma unroll
        for (int m = 0; m < 4; ++m) {
            bf16_t* rowp = O + (size_t)(row0 + ai * HALF + m * 16) * DM;
            float o[8];
#pragma unroll
            for (int n = 0; n < 2; ++n) { const f32x4 a = acc[ai][0][m][n] + bv[0][n], g = acc[ai][1][m][n] + bv[1][n];
#pragma unroll
                for (int j = 0; j < 4; ++j) {
                    if (T == 0) o[4 * n + j] = a[j] * fsigmoid(g[j]);
                    else {
                        const float ea = __builtin_amdgcn_exp2f(-1.4426950408889634f * 1.5957691216057308f * (a[j] + 0.044715f * a[j] * a[j] * a[j]));
                        const float eg = __builtin_amdgcn_exp2f(-1.4426950408889634f * g[j]);
                        o[4 * n + j] = a[j] * g[j] * __builtin_amdgcn_rcpf((1.0f + ea) * (1.0f + eg));
                    } } }
            u32x4 w; w.x = pk2(o[0], o[1]); w.y = pk2(o[2], o[3]); w.z = pk2(o[4], o[5]); w.w = pk2(o[6], o[7]);
            *(u32x4*)rowp = w;
        }
}
template <int T  > __device__ __forceinline__ void epi_solo(const f32x4 (&acc)[2][2][4][2], const f32x4 (&bv)[2][2], bf16_t* O, int row0) {
#pragma unroll
    for (int ai = 0; ai < 2; ++ai)
#pragma unroll
        for (int m = 0; m < 4; ++m) {
            bf16_t* rowp = O + (size_t)(row0 + ai * HALF + m * 16) * DM;
#pragma unroll
            for (int bj = 0; bj < 2; ++bj) {
                float o[8];
#pragma unroll
                for (int n = 0; n < 2; ++n) { const f32x4 a = acc[ai][bj][m][n] + bv[bj][n];
#pragma unroll
                    for (int j = 0; j < 4; ++j) o[4 * n + j] = act1<T>(a[j]); }
                u32x4 w; w.x = pk2(o[0], o[1]); w.y = pk2(o[2], o[3]); w.z = pk2(o[4], o[5]); w.w = pk2(o[6], o[7]);
                *(u32x4*)(rowp + bj * HALF) = w;
            }
        }
}
struct EpiP1 {
    static constexpr bool PERM = true, TWICE = true;
    const float* biasP; unsigned char* ws;
    __device__ __forceinline__ bool operator()(f32x4 (&acc)[2][2][4][2], const Unit& u, int wr, int wc, int fr, int fq) const {
        const int tile = u.pn;
        const int row0 = u.pm * BM + wr * 64 + fr, qc = wc * 32 + 8 * fq;
        f32x4 bv[2][2];
#pragma unroll
        for (int bj = 0; bj < 2; ++bj)
#pragma unroll
            for (int n = 0; n < 2; ++n) bv[bj][n] = *(const f32x4*)(biasP + tile * 256 + bj * HALF + qc + 4 * n);
        if (tile < 8) epi_pair<0>(acc, bv, (bf16_t*)(ws + WS_H) + (tile & 7) * 128 + qc, row0);
        else if (tile < 16) epi_pair<1>(acc, bv, (bf16_t*)(ws + WS_UB) + (tile & 7) * 128 + qc, row0);
        else if (tile < 20) epi_solo<0>(acc, bv, (bf16_t*)(ws + WS_SA) + (tile & 3) * 256 + qc, row0);
        else if (tile < 24) epi_solo<1>(acc, bv, (bf16_t*)(ws + WS_V) + (tile & 3) * 256 + qc, row0);
        else epi_solo<2>(acc, bv, (bf16_t*)(ws + (tile < 28 ? WS_GA : WS_GB)) + (tile & 3) * 256 + qc, row0);
        return false;
    }
};

struct EpiP3 {
    static constexpr bool PERM = true, TWICE = false;
    const bf16_t *GA, *GB; bf16_t* MIX;
    __device__ __forceinline__ bool operator()(f32x4 (&acc)[2][2][4][2], const Unit& u, int wr, int wc, int fr, int fq) const {
        const int row0 = u.pm * BM + wr * 64 + fr, col0 = u.pn * BM + wc * 32 + 8 * fq;
        if (u.kind == 0) {
#pragma unroll
            for (int ai = 0; ai < 2; ++ai)
#pragma unroll
                for (int m = 0; m < 4; ++m) {
                    const size_t ro = (size_t)(row0 + ai * HALF + m * 16) * DM + col0;
#pragma unroll
                    for (int bj = 0; bj < 2; ++bj) {
                        const u32x4 gb = *(const u32x4*)(GB + ro + bj * HALF), ga = *(const u32x4*)(GA + ro + bj * HALF);
                        const float b[8] = {bf_lo(gb.x), bf_hi(gb.x), bf_lo(gb.y), bf_hi(gb.y), bf_lo(gb.z), bf_hi(gb.z), bf_lo(gb.w), bf_hi(gb.w)};
                        const float a[8] = {bf_lo(ga.x), bf_hi(ga.x), bf_lo(ga.y), bf_hi(ga.y), bf_lo(ga.z), bf_hi(ga.z), bf_lo(ga.w), bf_hi(ga.w)};
#pragma unroll
                        for (int n = 0; n < 2; ++n)
#pragma unroll
                            for (int j = 0; j < 4; ++j) acc[ai][bj][m][n][j] *= a[4 * n + j] * __builtin_amdgcn_rcpf(b[4 * n + j]);
                    }
                }
            return true;
        }
#pragma unroll
        for (int ai = 0; ai < 2; ++ai)
#pragma unroll
            for (int m = 0; m < 4; ++m) {
                const size_t ro = (size_t)(row0 + ai * HALF + m * 16) * DM + col0;
#pragma unroll
                for (int bj = 0; bj < 2; ++bj) {
                    const u32x4 gb = *(const u32x4*)(GB + ro + bj * HALF);
                    const float b[8] = {bf_lo(gb.x), bf_hi(gb.x), bf_lo(gb.y), bf_hi(gb.y), bf_lo(gb.z), bf_hi(gb.z), bf_lo(gb.w), bf_hi(gb.w)};
                    float o[8];
#pragma unroll
                    for (int n = 0; n < 2; ++n)
#pragma unroll
                        for (int j = 0; j < 4; ++j) o[4 * n + j] = acc[ai][bj][m][n][j] * b[4 * n + j];
                    u32x4 w; w.x = pk2(o[0], o[1]); w.y = pk2(o[2], o[3]); w.z = pk2(o[4], o[5]); w.w = pk2(o[6], o[7]);
                    *(u32x4*)(MIX + ro + bj * HALF) = w;
                }
            }
        return false;
    }
};

struct EpiP4 {
    static constexpr bool PERM = false, TWICE = false;
    const float *x, *bo; float* out; float* stat;
    __device__ __forceinline__ bool operator()(f32x4 (&acc)[2][2][4][2], const Unit& u, int wr, int wc, int fr, int fq) const {
        const int row0 = u.pm * BM + wr * 64 + fr, col0 = u.pn * BM + wc * 32 + 4 * fq;
        f32x4 bv[2][2];
#pragma unroll
        for (int bj = 0; bj < 2; ++bj)
#pragma unroll
            for (int n = 0; n < 2; ++n) bv[bj][n] = *(const f32x4*)(bo + col0 + bj * HALF + n * 16);
#pragma unroll
        for (int ai = 0; ai < 2; ++ai)
#pragma unroll
            for (int m = 0; m < 4; ++m) {
                const int row = row0 + ai * HALF + m * 16;
                const size_t ro = (size_t)row * DM + col0;
                float s1 = 0.f, s2 = 0.f;
#pragma unroll
                for (int bj = 0; bj < 2; ++bj)
#pragma unroll
                    for (int n = 0; n < 2; ++n) {
                        const f32x4 xv = *(const f32x4*)(x + ro + bj * HALF + n * 16);
                        const f32x4 y = acc[ai][bj][m][n] + bv[bj][n] + ALPHA * xv;
                        *(f32x4*)(out + ro + bj * HALF + n * 16) = y;
                        s1 += (y[0] + y[1]) + (y[2] + y[3]); s2 += (y[0] * y[0] + y[1] * y[1]) + (y[2] * y[2] + y[3] * y[3]);
                    }
                s1 += __shfl_xor(s1, 16); s1 += __shfl_xor(s1, 32); s2 += __shfl_xor(s2, 16); s2 += __shfl_xor(s2, 32);
                if (fq == 0) { __hip_atomic_fetch_add(stat + 2 * row, s1, __ATOMIC_RELAXED, __HIP_MEMORY_SCOPE_AGENT); __hip_atomic_fetch_add(stat + 2 * row + 1, s2, __ATOMIC_RELAXED, __HIP_MEMORY_SCOPE_AGENT); }
            }
        return false;
    }
};

template <bool PERMUTE>
__device__ __forceinline__ void p0_transpose_item(const float* W, int K, int N, bf16_t* WT, LAS float* scr, int item, int lane) {
    const int nblk = N / 32, kb = item / nblk, nb = item % nblk, k0 = 64 * kb, n0 = 32 * nb;
    const int src0 = PERMUTE ? orig_col(n0) : n0;
#pragma unroll 8
    for (int i = 0; i < 32; ++i) { const int kk = 2 * i + (lane >> 5); scr[kk * 33 + (lane & 31)] = W[(size_t)(k0 + kk) * N + src0 + (lane & 31)]; }
    asm volatile("s_waitcnt lgkmcnt(0)" ::: "memory");
    const int c = lane & 7;
#pragma unroll
    for (int j = 0; j < 4; ++j) { const int n = (lane >> 3) + 8 * j; const LAS float* s = scr + (8 * c) * 33 + n;
        u32x4 o; o.x = pk2(s[0 * 33], s[1 * 33]); o.y = pk2(s[2 * 33], s[3 * 33]); o.z = pk2(s[4 * 33], s[5 * 33]); o.w = pk2(s[6 * 33], s[7 * 33]);
        *(u32x4*)(WT + (size_t)(n0 + n) * K + k0 + 8 * c) = o; }
    asm volatile("s_waitcnt lgkmcnt(0)" ::: "memory");
}

__device__ __forceinline__ void p0_prologue(const Args& a, LAS unsigned char* lds, int tid, int wave, int lane) {
    unsigned char* ws = a.ws;
    const size_t gt = (size_t)blockIdx.x * 512 + tid, GT = (size_t)gridDim.x * 512;
    LAS float* scr = (LAS float*)(lds + wave * 16384);
    const int gw = blockIdx.x * 8 + wave, NGW = gridDim.x * 8;
    constexpr int I_IN = (DM / 64) * (DIN / 32), I_SQ = (DM / 64) * (DM / 32);
    for (int it = gw; it < I_IN + 3 * I_SQ; it += NGW) {
        int r = it;
        if (r < I_IN) { p0_transpose_item<true>(a.in[1], DM, DIN, (bf16_t*)(ws + WS_WIN), scr, r, lane); continue; } r -= I_IN;
        if (r < I_SQ) { p0_transpose_item<false>(a.in[11], DM, DM, (bf16_t*)(ws + WS_WPA), scr, r, lane); continue; } r -= I_SQ;
        if (r < I_SQ) { p0_transpose_item<false>(a.in[12], DM, DM, (bf16_t*)(ws + WS_WPB), scr, r, lane); continue; } r -= I_SQ;
        p0_transpose_item<false>(a.in[13], DM, DM, (bf16_t*)(ws + WS_WO), scr, r, lane);
    }
    if (gt < 8 * 128 * 128) { const int t = (int)(gt >> 7) & 127, s = (int)gt & 127; const float w = a.in[9][gt]; ((bf16_t*)(ws + WS_WS))[gt] = (s <= t) ? (bf16_t)(pk2(w, 0.f) & 0xffffu) : (bf16_t)0; }
    if (gt < DIN) ((float*)(ws + WS_BIAS))[gt] = a.in[2][orig_col((int)gt)];
    if (gt < 2 * NTOK) ((float*)(ws + WS_STAT))[gt] = 0.f;
    const f32x4* x4 = (const f32x4*)a.in[0]; u32x4* xb = (u32x4*)(ws + WS_XB);
    for (size_t i = gt; i < (size_t)NTOK * DM / 8; i += GT) {
        const f32x4 p = x4[2 * i], q = x4[2 * i + 1];
        u32x4 o; o.x = pk2(p[0], p[1]); o.y = pk2(p[2], p[3]); o.z = pk2(q[0], q[1]); o.w = pk2(q[2], q[3]);
        xb[i] = o;
    }
}

__device__ __forceinline__ void p2_conv(const Args& a, int chunk, int wave, int lane) {
    const bf16_t* H = (const bf16_t*)(a.ws + WS_H); bf16_t* SA = (bf16_t*)(a.ws + WS_SA);
    const float *conv_w = a.in[3], *conv_b = a.in[4], *gn_g = a.in[5], *gn_b = a.in[6];
    const bool has_prev = (chunk & 15) != 0;
    const long R0 = (long)chunk * 128;
    const int t0 = wave * 16;
    for (int g = 0; g < 8; ++g) {
        const int c = g * 128 + 2 * lane;
        f32x2 w[31];
#pragma unroll
        for (int j = 0; j < 31; ++j) w[j] = *(const f32x2*)(conv_w + j * DM + c);
        const f32x2 cb = *(const f32x2*)(conv_b + c);
        f32x2 acc[16];
#pragma unroll
        for (int t = 0; t < 16; ++t) acc[t] = cb;
#pragma unroll
        for (int idx = 0; idx < 46; ++idx) {
            const int tok = t0 - 30 + idx;
            unsigned raw = 0u;
            if (tok >= 0 || has_prev) raw = *(const unsigned*)(H + (R0 + tok) * DM + c);
            const f32x2 hv = {bf_lo(raw), bf_hi(raw)};
#pragma unroll
            for (int t = 0; t < 16; ++t) { const int j = idx - t; if (j >= 0 && j <= 30) acc[t] += w[j] * hv; }
        }
        const f32x2 gg = *(const f32x2*)(gn_g + c), gb = *(const f32x2*)(gn_b + c);
#pragma unroll
        for (int t = 0; t < 16; ++t) {
            const float s1 = wave_sum(acc[t].x + acc[t].y), s2 = wave_sum(acc[t].x * acc[t].x + acc[t].y * acc[t].y);
            const float mean = s1 * (1.f / 128.f), var = fmaxf(s2 * (1.f / 128.f) - mean * mean, 0.f), rstd = __builtin_amdgcn_rsqf(var + LN_EPS);
            const float y0 = (acc[t].x - mean) * rstd * gg.x + gb.x, y1 = (acc[t].y - mean) * rstd * gg.y + gb.y;
            unsigned* p = (unsigned*)(SA + (R0 + t0 + t) * DM + c);
            const unsigned sraw = *p;
            *p = pk2(fsilu(y0) * bf_lo(sraw), fsilu(y1) * bf_hi(sraw));
        }
    }
}

__device__ __forceinline__ void p2_gmlp(const Args& a, LAS unsigned char* lds, int chunk, int tid, int wave, int lane) {
    const bf16_t* V = (const bf16_t*)(a.ws + WS_V); bf16_t* UB = (bf16_t*)(a.ws + WS_UB); const bf16_t* WsB = (const bf16_t*)(a.ws + WS_WS);
    const float *ln_g = a.in[7], *ln_b = a.in[8], *b_sp = a.in[10];
    LAS float* mu = (LAS float*)lds; LAS float* rs = mu + 128;
    LAS unsigned char* vt = lds + 1024;
    const long R0 = (long)chunk * 128;
    const int t0 = wave * 16;
#pragma unroll 1
    for (int tt = 0; tt < 16; tt += 4) {
        u32x4 r[4][2];
#pragma unroll
        for (int q = 0; q < 4; ++q) { const bf16_t* row = V + (R0 + t0 + tt + q) * DM; r[q][0] = *(const u32x4*)(row + lane * 8); r[q][1] = *(const u32x4*)(row + 512 + lane * 8); }
#pragma unroll
        for (int q = 0; q < 4; ++q) {
            float s1 = 0.f, s2 = 0.f;
#pragma unroll
            for (int k = 0; k < 2; ++k)
#pragma unroll
                for (int e = 0; e < 4; ++e) { const float lo = bf_lo(r[q][k][e]), hi = bf_hi(r[q][k][e]); s1 += lo + hi; s2 += lo * lo + hi * hi; }
            s1 = wave_sum(s1); s2 = wave_sum(s2);
            const float mean = s1 * (1.f / 1024.f), var = fmaxf(s2 * (1.f / 1024.f) - mean * mean, 0.f);
            if (lane == 0) { mu[t0 + tt + q] = mean; rs[t0 + tt + q] = __builtin_amdgcn_rsqf(var + LN_EPS); }
        }
    }
    __syncthreads();
    const int d = tid & 127, sgq = tid >> 7;
    const int wt = wave >> 1, wd = wave & 1, fr = lane & 15, fq = lane >> 4;
#pragma unroll 1
    for (int h = 0; h < 8; ++h) {
        LAS unsigned char* buf = vt + (h & 1) * 32768;
        const float g = ln_g[h * 128 + d], be = ln_b[h * 128 + d];
#pragma unroll
        for (int i = 0; i < 4; ++i) {
            const int sg = sgq * 4 + i;
            const bf16_t* src = V + (R0 + sg * 8) * DM + h * 128 + d;
            unsigned raw[8];
#pragma unroll
            for (int e = 0; e < 8; ++e) raw[e] = src[(size_t)e * DM];
            float v[8];
#pragma unroll
            for (int e = 0; e < 8; ++e) v[e] = (__uint_as_float(raw[e] << 16) - mu[sg * 8 + e]) * rs[sg * 8 + e] * g + be;
            u32x4 o; o.x = pk2(v[0], v[1]); o.y = pk2(v[2], v[3]); o.z = pk2(v[4], v[5]); o.w = pk2(v[6], v[7]);
            *(LAS u32x4*)(buf + d * 256 + ((sg + d) & 15) * 16) = o;
        }
        __syncthreads();
        f32x4 acc[2][4];
#pragma unroll
        for (int mi = 0; mi < 2; ++mi)
#pragma unroll
            for (int ni = 0; ni < 4; ++ni) acc[mi][ni] = (f32x4){0.f, 0.f, 0.f, 0.f};
        for (int ks = 0; ks <= wt; ++ks) {
            bf16x8 wf[2], vf[4];
#pragma unroll
            for (int mi = 0; mi < 2; ++mi) wf[mi] = *(const bf16x8*)(WsB + (size_t)((h * 128 + 32 * wt + 16 * mi + fr) * 128 + ks * 32 + fq * 8));
#pragma unroll
            for (int ni = 0; ni < 4; ++ni) { const int dd = 64 * wd + 16 * ni + fr; vf[ni] = *(const LAS bf16x8*)(buf + dd * 256 + (((ks * 4 + fq) + dd) & 15) * 16); }
#pragma unroll
            for (int mi = 0; mi < 2; ++mi)
#pragma unroll
                for (int ni = 0; ni < 4; ++ni) acc[mi][ni] = __builtin_amdgcn_mfma_f32_16x16x32_bf16(vf[ni], wf[mi], acc[mi][ni], 0, 0, 0);
        }
#pragma unroll
        for (int mi = 0; mi < 2; ++mi) {
            const int t = 32 * wt + 16 * mi + fr;
            const float bsp = b_sp[h * 128 + t];
#pragma unroll
            for (int ni = 0; ni < 4; ++ni) {
                u32x2* p = (u32x2*)(UB + (R0 + t) * DM + h * 128 + 64 * wd + 16 * ni + 4 * fq);
                const u32x2 ub = *p;
                u32x2 o; o.x = pk2((acc[mi][ni][0] + bsp) * bf_lo(ub.x), (acc[mi][ni][1] + bsp) * bf_hi(ub.x));
                o.y = pk2((acc[mi][ni][2] + bsp) * bf_lo(ub.y), (acc[mi][ni][3] + bsp) * bf_hi(ub.y));
                *p = o;
            }
        }
    }
    __syncthreads();
}

__device__ __forceinline__ void p5_ln(const Args& a, int wave, int lane) {
    const float* stat = (const float*)(a.ws + WS_STAT);
    const f32x4* g4 = (const f32x4*)a.in[15]; const f32x4* b4 = (const f32x4*)a.in[16];
    f32x4 gg[4], bb[4];
#pragma unroll
    for (int j = 0; j < 4; ++j) { gg[j] = g4[lane + 64 * j]; bb[j] = b4[lane + 64 * j]; }
    for (int row = blockIdx.x * 8 + wave; row < NTOK; row += gridDim.x * 8) {
        const float s1 = stat[2 * row], s2 = stat[2 * row + 1];
        const float mean = s1 * (1.f / 1024.f), var = fmaxf(s2 * (1.f / 1024.f) - mean * mean, 0.f), rstd = __builtin_amdgcn_rsqf(var + LN_EPS);
        f32x4* p = (f32x4*)(a.out + (size_t)row * DM) + lane;
        f32x4 v[4];
#pragma unroll
        for (int j = 0; j < 4; ++j) v[j] = p[64 * j];
#pragma unroll
        for (int j = 0; j < 4; ++j) p[64 * j] = (v[j] - mean) * rstd * gg[j] + bb[j];
    }
}

__global__ void __launch_bounds__(512) fwd_megakernel(Args a) {
    extern __shared__ __attribute__((aligned(16))) unsigned char lds_raw[];
    LAS unsigned char* lds = (LAS unsigned char*)lds_raw;
    cg::grid_group grid = cg::this_grid();
    const int tid = threadIdx.x, lane = tid & 63, wave = __builtin_amdgcn_readfirstlane(tid >> 6);
    const int G = gridDim.x, c = blockIdx.x;
    unsigned char* ws = a.ws;
    const int lo = a.ph_lo, hi = a.ph_hi;
#define IN(k) (lo <= (k) && (k) < hi)
#ifdef PROBE_PHASE
    unsigned long long tstamp[7]; int nst = 0;
#define STAMP() do { tstamp[nst++] = __builtin_amdgcn_s_memrealtime(); } while (0)
#else
#define STAMP() do {} while (0)
#endif
#define SEAM(k) do { if (IN(k) && IN((k) + 1)) grid.sync(); STAMP(); } while (0)
    STAMP();

    if (IN(0)) { p0_prologue(a, lds, tid, wave, lane); }
    SEAM(0);
    if (IN(1)) {
        SchedSimple S{(const char*)(ws + WS_XB), (const char*)(ws + WS_WIN), NTOK / BM, DIN / BM, G, c};
        EpiP1 E{(const float*)(ws + WS_BIAS), ws};
        gemm_phase(lds, S, E);
    }
    SEAM(1);
    if (IN(2)) {
        for (int chunk = c; chunk < NTOK / 128; chunk += G) { p2_gmlp(a, lds, chunk, tid, wave, lane); p2_conv(a, chunk, wave, lane); }
    }
    SEAM(2);
    if (IN(3)) {
        SchedDual S{(const char*)(ws + WS_SA), (const char*)(ws + WS_WPA), (const char*)(ws + WS_UB), (const char*)(ws + WS_WPB), NTOK / BM, DM / BM, G, c};
        EpiP3 E{(const bf16_t*)(ws + WS_GA), (const bf16_t*)(ws + WS_GB), (bf16_t*)(ws + WS_MIX)};
        gemm_phase(lds, S, E);
    }
    SEAM(3);
    if (IN(4)) {
        SchedSimple S{(const char*)(ws + WS_MIX), (const char*)(ws + WS_WO), NTOK / BM, DM / BM, G, c};
        EpiP4 E{a.in[0], a.in[14], a.out, (float*)(ws + WS_STAT)};
        gemm_phase(lds, S, E);
    }
    SEAM(4);
    if (IN(5)) { p5_ln(a, wave, lane); }
#ifdef PROBE_PHASE
    STAMP();
    if (c == 0 && tid == 0) a.out[0] += 16.f * floorf((float)(tstamp[PROBE_PHASE + 1] - tstamp[PROBE_PHASE]) * 0.01f * (1.f / 16.f) + 0.5f);
#endif
}

extern "C" void kernel_launch(void* const* d_in, const int* in_sizes, int n_in, void* d_out, int out_size, void* d_ws, size_t ws_size, hipStream_t stream) {
    static int grid = 0;
    if (grid == 0) {
        if (n_in != 17 || in_sizes[0] != NTOK * DM || out_size != NTOK * DM || ws_size < WS_END) {
            fprintf(stderr, "kernel_launch: unexpected shapes (n_in %d, in0 %d, out %d, ws %zu < %zu); nothing launched\n", n_in, n_in > 0 ? in_sizes[0] : -1, out_size, ws_size, (size_t)WS_END); grid = -1; return; }
        int dev = 0, cus = 0, per_cu = 0;
        (void)hipGetDevice(&dev);
        (void)hipDeviceGetAttribute(&cus, hipDeviceAttributeMultiprocessorCount, dev);
        if (hipFuncSetAttribute((const void*)fwd_megakernel, hipFuncAttributeMaxDynamicSharedMemorySize, LDS_BYTES) != hipSuccess) { fprintf(stderr, "kernel_launch: hipFuncSetAttribute failed\n"); grid = -1; return; }
        if (hipOccupancyMaxActiveBlocksPerMultiprocessor(&per_cu, (const void*)fwd_megakernel, 512, LDS_BYTES) != hipSuccess || per_cu < 1) { fprintf(stderr, "kernel_launch: occupancy query failed (%d)\n", per_cu); (void)hipGetLastError(); per_cu = 1; }
        if (per_cu > 1) per_cu = 1;
        grid = cus * per_cu;
    }
    if (grid < 0) return;
    Args a{};
    for (int i = 0; i < 17; ++i) a.in[i] = (const float*)d_in[i];
    a.out = (float*)d_out; a.ws = (unsigned char*)d_ws;
#if N_LAUNCHES == 1
    a.ph_lo = 0; a.ph_hi = 6;
    void* args[] = {&a};
    hipError_t e = hipLaunchCooperativeKernel((const void*)fwd_megakernel, dim3(grid), dim3(512), args, LDS_BYTES, stream);
    if (e != hipSuccess) fprintf(stderr, "cooperative launch failed: %s (grid %d)\n", hipGetErrorString(e), grid);
#else
    for (int ph = 0; ph < 6; ++ph) {
        a.ph_lo = ph; a.ph_hi = ph + 1;
        hipLaunchKernelGGL(fwd_megakernel, dim3(grid), dim3(512), LDS_BYTES, stream, a);
    }
#endif
}
```

```cpp
#include <hip/hip_runtime.h>
#include <hip/hip_cooperative_groups.h>
#include <cstdio>
#include <cstdint>
namespace cg = cooperative_groups;

#ifndef N_LAUNCHES
#define N_LAUNCHES 1
#endif

#define LAS __attribute__((address_space(3)))
typedef unsigned short bf16_t;
typedef short bf16x8 __attribute__((ext_vector_type(8)));
typedef float f32x4 __attribute__((ext_vector_type(4)));
typedef float f32x2 __attribute__((ext_vector_type(2)));
typedef unsigned u32x4 __attribute__((ext_vector_type(4)));
typedef unsigned u32x2 __attribute__((ext_vector_type(2)));

constexpr int DM = 1024, NTOK = 32768, DIN = 8192;
constexpr float LN_EPS = 1e-5f;
constexpr float ALPHA = 1.189207115002721f;
constexpr int BM = 256, BK = 64, HALF = 128, HTB = HALF * BK * 2, STAGE_BYTES = 8 * HTB, WGM = 8;
constexpr int BIAS_OFF = STAGE_BYTES;
constexpr int LDS_BYTES = STAGE_BYTES + DIN * 4;
constexpr int KDIM = 1024;

constexpr size_t MiB = (size_t)1 << 20;
constexpr size_t WS_XB = 0, WS_H = 64 * MiB, WS_SA = 128 * MiB, WS_UB = 192 * MiB, WS_V = 256 * MiB, WS_GA = 320 * MiB, WS_GB = 384 * MiB;
constexpr size_t WS_WIN = 448 * MiB, WS_WPA = 464 * MiB, WS_WPB = 466 * MiB, WS_WO = 468 * MiB, WS_WS = 470 * MiB;
constexpr size_t WS_BIAS = WS_WS + 256 * 1024, WS_STAT = WS_BIAS + 256 * 1024, WS_VSTAT = WS_STAT + 256 * 1024, WS_CTL = 471 * MiB, WS_END = 472 * MiB;
constexpr size_t WS_MIX = WS_XB;
constexpr size_t CTL_BYTES = 32768;

struct Args {
    const float* in[17];
    float* out;
    unsigned char* ws;
    int ph_lo, ph_hi;
};

typedef __bf16 bf16x2_t __attribute__((ext_vector_type(2)));
__device__ __forceinline__ unsigned pk2(float lo, float hi) { const f32x2 v = {lo, hi}; return __builtin_bit_cast(unsigned, __builtin_convertvector(v, bf16x2_t)); }
__device__ __forceinline__ float bf_lo(unsigned u) { return __uint_as_float(u << 16); }
__device__ __forceinline__ float bf_hi(unsigned u) { return __uint_as_float(u & 0xffff0000u); }
#ifdef PROBE_NOACT
__device__ __forceinline__ float fsigmoid(float x) { return 0.5f + 0.01f * x; }
__device__ __forceinline__ float fsigmoid_unused(float x) {
#else
__device__ __forceinline__ float fsigmoid(float x) {
#endif
    return __builtin_amdgcn_rcpf(1.0f + __builtin_amdgcn_exp2f(-1.4426950408889634f * x)); }
__device__ __forceinline__ float fsilu(float x) { return x * fsigmoid(x); }
__device__ __forceinline__ float fgelu(float x) { return x * fsigmoid(1.5957691216057308f * (x + 0.044715f * x * x * x)); }
__device__ __forceinline__ float wave_sum(float v) {
#pragma unroll
    for (int o = 1; o < 64; o <<= 1) v += __shfl_xor(v, o);
    return v;
}
__host__ __device__ __forceinline__ int orig_col(int p) {
    const int tile = p >> 8, q = p & 255;
    if (tile < 8) return (q < 128) ? tile * 128 + q : 1024 + tile * 128 + (q - 128);
    if (tile < 16) { const int tt = tile - 8; return (q < 128) ? 3072 + tt * 128 + q : 5120 + tt * 128 + (q - 128); }
    if (tile < 20) return 2048 + (tile - 16) * 256 + q;
    if (tile < 24) return 4096 + (tile - 20) * 256 + q;
    if (tile < 28) return 6144 + (tile - 24) * 256 + q;
    return 7168 + (tile - 28) * 256 + q;
}

__host__ __device__ __forceinline__ int lds_byte(int r, int c) { const int st = (r >> 4) * 2 + (c >> 5), rr = r & 15, cc = c & 31, ob = rr * 64 + cc * 2; return st * 1024 + (ob ^ (((ob >> 9) & 1) << 5)); }
__host__ __device__ __forceinline__ void stage_rc(int b, int& R, int& C) { const int st = b / 1024, sb = b % 1024, swz = sb ^ (((sb >> 9) & 1) << 5); R = (st >> 1) * 16 + swz / 64; C = (st & 1) * 32 + (swz % 64) / 2; }
__host__ __device__ __forceinline__ int perm32(int rho) { const int n = rho >> 4, i = rho & 15; return 8 * (i >> 2) + 4 * n + (i & 3); }

struct Unit { const char* A; const char* B; int pm, pn, kind; };

__device__ __forceinline__ bool tile_order(long L, int nM, int nN, int& pm, int& pn) {
    const int nwg = nM * nN; if (L >= nwg) return false;
    int wgid = (int)L; { const int q = nwg / 8, r = nwg % 8, xcd = wgid % 8, off = wgid / 8; wgid = (xcd < r ? xcd * (q + 1) : r * (q + 1) + (xcd - r) * q) + off; }
    const int nig = WGM * nN, gid = wgid / nig, fm = gid * WGM, gsz = (nM - fm) < WGM ? (nM - fm) : WGM;
    pm = fm + ((wgid % nig) % gsz); pn = (wgid % nig) / gsz; return true;
}
constexpr size_t TSTEP = (size_t)BM * KDIM * 2;

struct SchedSimple {
    const char* A; const char* B; int nM, nN, G, c;
    __device__ __forceinline__ bool next(int i, Unit& u) const {
        if (!tile_order((long)i * G + c, nM, nN, u.pm, u.pn)) return false;
        u.A = A + (size_t)u.pm * TSTEP; u.B = B + (size_t)u.pn * TSTEP; u.kind = 1; return true;
    }
};
struct SchedDual {
    const char *A0, *B0, *A1, *B1; int nM, nN, G, c;
    __device__ __forceinline__ bool next(int i, Unit& u) const {
        if (!tile_order((long)(i >> 1) * G + c, nM, nN, u.pm, u.pn)) return false;
        u.kind = i & 1;
        u.A = (u.kind ? A1 : A0) + (size_t)u.pm * TSTEP; u.B = (u.kind ? B1 : B0) + (size_t)u.pn * TSTEP; return true;
    }
};

template <class Epi, class Sched>
__device__ __forceinline__ void gemm_phase(LAS unsigned char* lds, const Sched& S, const Epi& E) {
    const int tid = threadIdx.x, wid = __builtin_amdgcn_readfirstlane(tid >> 6), lane = tid & 63, wr = wid >> 2, wc = wid & 3, fr = lane & 15, fq = lane >> 4;
    constexpr int K = KDIM, nt = K / BK;
    unsigned voffA[2], voffB[2];
#pragma unroll
    for (int i = 0; i < 2; ++i) { int R, C; stage_rc(tid * 16 + i * 8192, R, C); const int Rb = Epi::PERM ? ((R & ~31) + perm32(R & 31)) : R;
        voffA[i] = (unsigned)(R * K + C) * 2u; voffB[i] = (unsigned)(Rb * K + C) * 2u; }
    constexpr size_t kstep = (size_t)(BK * 2);
    constexpr size_t hstep = (size_t)HALF * K * 2;
    const unsigned ldsw = (unsigned)wid * 1024u;
    const int aoff = lds_byte(wr * 64 + fr, fq * 8), boff = lds_byte(wc * 32 + fr, fq * 8);
#define PG8_SA(b, h) (((b) * 2 + (h)) * HTB)
#define PG8_SB(b, h) ((4 + (b) * 2 + (h)) * HTB)
#define PG8_STAGE(bufoff, gbase, voff) do { _Pragma("unroll") for (int _i = 0; _i < 2; ++_i) \
        __builtin_amdgcn_global_load_lds((const unsigned*)((const char*)(gbase) + (voff)[_i]), (LAS unsigned*)(lds + (bufoff) + ldsw + _i * 8192), 16, 0, 0); } while (0)
#define PG8_LDA(dst, b, h) do { _Pragma("unroll") for (int m = 0; m < 4; ++m) _Pragma("unroll") for (int k = 0; k < 2; ++k) dst[m][k] = *(const LAS bf16x8*)(lds + PG8_SA(b, h) + aoff + m * 2048 + k * 1024); } while (0)
#define PG8_LDB(dst, b, h) do { _Pragma("unroll") for (int n = 0; n < 2; ++n) _Pragma("unroll") for (int k = 0; k < 2; ++k) dst[n][k] = *(const LAS bf16x8*)(lds + PG8_SB(b, h) + boff + n * 2048 + k * 1024); } while (0)
#define PG8_MMA(ai, bj, At, Bt) do { __builtin_amdgcn_s_setprio(1); _Pragma("unroll") for (int m = 0; m < 4; ++m) _Pragma("unroll") for (int n = 0; n < 2; ++n) _Pragma("unroll") for (int k = 0; k < 2; ++k) \
        acc[ai][bj][m][n] = __builtin_amdgcn_mfma_f32_16x16x32_bf16(Bt[n][k], At[m][k], acc[ai][bj][m][n], 0, 0, 0); __builtin_amdgcn_s_setprio(0); } while (0)
#define PG8_WAIT_V(n) asm volatile("s_waitcnt vmcnt(" #n ")" ::: "memory")
#define PG8_WAIT_L(n) asm volatile("s_waitcnt lgkmcnt(" #n ")" ::: "memory")
#define PG8_BAR __builtin_amdgcn_s_barrier()
#define PG8_SCHED __builtin_amdgcn_sched_barrier(0)
    Unit cur, nxt; int ui = 0;
    if (!S.next(0, cur)) return;
    f32x4 acc[2][2][4][2];
#pragma unroll
    for (int a = 0; a < 2; ++a)
#pragma unroll
        for (int b = 0; b < 2; ++b)
#pragma unroll
            for (int m = 0; m < 4; ++m)
#pragma unroll
                for (int n = 0; n < 2; ++n) acc[a][b][m][n] = (f32x4){0.f, 0.f, 0.f, 0.f};
    bf16x8 At[4][2], B0[2][2], B1[2][2];
    const char* cA = cur.A; const char* cB = cur.B;
    PG8_STAGE(PG8_SB(0, 0), cB, voffB); PG8_STAGE(PG8_SB(0, 1), cB + hstep, voffB); PG8_STAGE(PG8_SA(0, 0), cA, voffA); PG8_STAGE(PG8_SA(0, 1), cA + hstep, voffA);
    if (wr == 1) PG8_BAR;
    PG8_WAIT_V(2); PG8_BAR;
    PG8_STAGE(PG8_SB(1, 0), cB + kstep, voffB); PG8_STAGE(PG8_SA(1, 0), cA + kstep, voffA); PG8_STAGE(PG8_SB(1, 1), cB + hstep + kstep, voffB);
    PG8_WAIT_V(6); PG8_BAR;
    for (;;) {
        const bool has_next = S.next(ui + 1, nxt);
        const char* nA = has_next ? nxt.A : cA; const char* nB = has_next ? nxt.B : cB;
        for (int t = 0; t < nt; t += 2) {
            const bool last = (t == nt - 2);
            const char* a1 = cA + (size_t)(t + 1) * kstep;
            const char* a2 = last ? nA : cA + (size_t)(t + 2) * kstep; const char* b2 = last ? nB : cB + (size_t)(t + 2) * kstep;
            const char* a3 = a2 + kstep; const char* b3 = b2 + kstep;
            PG8_LDB(B0, 0, 0); PG8_LDB(B1, 0, 1); PG8_SCHED; PG8_LDA(At, 0, 0); PG8_STAGE(PG8_SA(1, 1), a1 + hstep, voffA);
            PG8_WAIT_V(8); PG8_WAIT_L(0); PG8_BAR; PG8_MMA(0, 0, At, B0); PG8_MMA(0, 1, At, B1); PG8_BAR; PG8_SCHED;
            PG8_LDA(At, 0, 1); PG8_STAGE(PG8_SB(0, 0), b2, voffB); PG8_STAGE(PG8_SB(0, 1), b2 + hstep, voffB); PG8_STAGE(PG8_SA(0, 0), a2, voffA);
            PG8_WAIT_V(8); PG8_WAIT_L(0); PG8_BAR; PG8_MMA(1, 0, At, B0); PG8_MMA(1, 1, At, B1); PG8_BAR; PG8_SCHED;
            PG8_LDB(B0, 1, 0); PG8_LDB(B1, 1, 1); PG8_SCHED; PG8_LDA(At, 1, 0); PG8_STAGE(PG8_SA(0, 1), a2 + hstep, voffA);
            PG8_WAIT_V(8); PG8_WAIT_L(0); PG8_BAR; PG8_MMA(0, 0, At, B0); PG8_MMA(0, 1, At, B1); PG8_BAR; PG8_SCHED;
            PG8_LDA(At, 1, 1); PG8_STAGE(PG8_SB(1, 0), b3, voffB); PG8_STAGE(PG8_SB(1, 1), b3 + hstep, voffB); PG8_STAGE(PG8_SA(1, 0), a3, voffA);
            PG8_WAIT_V(8); PG8_WAIT_L(0); PG8_BAR; PG8_MMA(1, 0, At, B0); PG8_MMA(1, 1, At, B1); PG8_BAR; PG8_SCHED;
        }
        if (wr == 0) PG8_BAR;
#ifdef PROBE_EPI2X
        if (Epi::TWICE) { E(acc, cur, wr, wc, fr, fq);
            _Pragma("unroll") for (int a = 0; a < 2; ++a) _Pragma("unroll") for (int b = 0; b < 2; ++b) _Pragma("unroll") for (int m = 0; m < 4; ++m) _Pragma("unroll") for (int n = 0; n < 2; ++n) asm volatile("" : "+v"(acc[a][b][m][n]) :: "memory"); }
#endif
        const bool keep = E(acc, cur, wr, wc, fr, fq);
        if (!has_next) break;
        if (!keep) {
#pragma unroll
            for (int a = 0; a < 2; ++a)
#pragma unroll
                for (int b = 0; b < 2; ++b)
#pragma unroll
                    for (int m = 0; m < 4; ++m)
#pragma unroll
                        for (int n = 0; n < 2; ++n) acc[a][b][m][n] = (f32x4){0.f, 0.f, 0.f, 0.f};
        }
        cur = nxt; cA = nA; cB = nB; ++ui;
        if (wr == 1) PG8_BAR;
    }
    PG8_WAIT_V(0);
    PG8_BAR;
#undef PG8_SA
#undef PG8_SB
#undef PG8_STAGE
#undef PG8_LDA
#undef PG8_LDB
#undef PG8_MMA
#undef PG8_WAIT_V
#undef PG8_WAIT_L
#undef PG8_BAR
#undef PG8_SCHED
}

template <int T> __device__ __forceinline__ float act1(float a) { return T == 0 ? fsilu(a) : T == 1 ? fgelu(a) : fsigmoid(a); }
template <int T  > __device__ __forceinline__ void epi_pair(const f32x4 (&acc)[2][2][4][2], const f32x4 (&bv)[2][2], bf16_t* O, int row0) {
#pragma unroll
    for (int ai = 0; ai < 2; ++ai)
#pragma unroll
        for (int m = 0; m < 4; ++m) {
            bf16_t* rowp = O + (size_t)(row0 + ai * HALF + m * 16) * DM;
            float o[8];
#pragma unroll
            for (int n = 0; n < 2; ++n) { const f32x4 a = acc[ai][0][m][n] + bv[0][n], g = acc[ai][1][m][n] + bv[1][n];
#pragma unroll
                for (int j = 0; j < 4; ++j) {
                    if (T == 0) o[4 * n + j] = a[j] * fsigmoid(g[j]);
                    else {
                        const float ea = __builtin_amdgcn_exp2f(-1.4426950408889634f * 1.5957691216057308f * (a[j] + 0.044715f * a[j] * a[j] * a[j]));
                        const float eg = __builtin_amdgcn_exp2f(-1.4426950408889634f * g[j]);
                        o[4 * n + j] = a[j] * g[j] * __builtin_amdgcn_rcpf((1.0f + ea) * (1.0f + eg));
                    } } }
            u32x4 w; w.x = pk2(o[0], o[1]); w.y = pk2(o[2], o[3]); w.z = pk2(o[4], o[5]); w.w = pk2(o[6], o[7]);
            *(u32x4*)rowp = w;
        }
}
template <int T  > __device__ __forceinline__ void epi_solo(const f32x4 (&acc)[2][2][4][2], const f32x4 (&bv)[2][2], bf16_t* O, int row0, float* vstat, int fq) {
#pragma unroll
    for (int ai = 0; ai < 2; ++ai)
#pragma unroll
        for (int m = 0; m < 4; ++m) {
            const int row = row0 + ai * HALF + m * 16;
            bf16_t* rowp = O + (size_t)row * DM;
            float s1 = 0.f, s2 = 0.f;
#pragma unroll
            for (int bj = 0; bj < 2; ++bj) {
                float o[8];
#pragma unroll
                for (int n = 0; n < 2; ++n) { const f32x4 a = acc[ai][bj][m][n] + bv[bj][n];
#pragma unroll
                    for (int j = 0; j < 4; ++j) { o[4 * n + j] = act1<T>(a[j]); if (T == 1) { s1 += o[4 * n + j]; s2 += o[4 * n + j] * o[4 * n + j]; } } }
                u32x4 w; w.x = pk2(o[0], o[1]); w.y = pk2(o[2], o[3]); w.z = pk2(o[4], o[5]); w.w = pk2(o[6], o[7]);
                *(u32x4*)(rowp + bj * HALF) = w;
            }
            if (T == 1) {
                s1 += __shfl_xor(s1, 16); s1 += __shfl_xor(s1, 32); s2 += __shfl_xor(s2, 16); s2 += __shfl_xor(s2, 32);
                if (fq == 0) { __hip_atomic_fetch_add(vstat + 2 * row, s1, __ATOMIC_RELAXED, __HIP_MEMORY_SCOPE_AGENT); __hip_atomic_fetch_add(vstat + 2 * row + 1, s2, __ATOMIC_RELAXED, __HIP_MEMORY_SCOPE_AGENT); }
            }
        }
}
struct EpiP1 {
    static constexpr bool PERM = true, TWICE = true;
    const LAS float* biasP; unsigned char* ws;
    __device__ __forceinline__ bool operator()(f32x4 (&acc)[2][2][4][2], const Unit& u, int wr, int wc, int fr, int fq) const {
        const int tile = u.pn;
        const int row0 = u.pm * BM + wr * 64 + fr, qc = wc * 32 + 8 * fq;
        f32x4 bv[2][2];
#pragma unroll
        for (int bj = 0; bj < 2; ++bj)
#pragma unroll
            for (int n = 0; n < 2; ++n) bv[bj][n] = *(const LAS f32x4*)(biasP + tile * 256 + bj * HALF + qc + 4 * n);
        if (tile < 8) epi_pair<0>(acc, bv, (bf16_t*)(ws + WS_H) + (tile & 7) * 128 + qc, row0);
        else if (tile < 16) epi_pair<1>(acc, bv, (bf16_t*)(ws + WS_UB) + (tile & 7) * 128 + qc, row0);
        else if (tile < 20) epi_solo<0>(acc, bv, (bf16_t*)(ws + WS_SA) + (tile & 3) * 256 + qc, row0, nullptr, fq);
        else if (tile < 24) epi_solo<1>(acc, bv, (bf16_t*)(ws + WS_V) + (tile & 3) * 256 + qc, row0, (float*)(ws + WS_VSTAT), fq);
        else epi_solo<2>(acc, bv, (bf16_t*)(ws + (tile < 28 ? WS_GA : WS_GB)) + (tile & 3) * 256 + qc, row0, nullptr, fq);
        return false;
    }
};

struct EpiP3 {
    static constexpr bool PERM = true, TWICE = false;
    const bf16_t *GA, *GB; bf16_t* MIX;
    __device__ __forceinline__ bool operator()(f32x4 (&acc)[2][2][4][2], const Unit& u, int wr, int wc, int fr, int fq) const {
        const int row0 = u.pm * BM + wr * 64 + fr, col0 = u.pn * BM + wc * 32 + 8 * fq;
        if (u.kind == 0) {
#pragma unroll
            for (int ai = 0; ai < 2; ++ai)
#pragma unroll
                for (int m = 0; m < 4; ++m) {
                    const size_t ro = (size_t)(row0 + ai * HALF + m * 16) * DM + col0;
#pragma unroll
                    for (int bj = 0; bj < 2; ++bj) {
                        const u32x4 gb = *(const u32x4*)(GB + ro + bj * HALF), ga = *(const u32x4*)(GA + ro + bj * HALF);
                        const float b[8] = {bf_lo(gb.x), bf_hi(gb.x), bf_lo(gb.y), bf_hi(gb.y), bf_lo(gb.z), bf_hi(gb.z), bf_lo(gb.w), bf_hi(gb.w)};
                        const float a[8] = {bf_lo(ga.x), bf_hi(ga.x), bf_lo(ga.y), bf_hi(ga.y), bf_lo(ga.z), bf_hi(ga.z), bf_lo(ga.w), bf_hi(ga.w)};
#pragma unroll
                        for (int n = 0; n < 2; ++n)
#pragma unroll
                            for (int j = 0; j < 4; ++j) acc[ai][bj][m][n][j] *= a[4 * n + j] * __builtin_amdgcn_rcpf(b[4 * n + j]);
                    }
                }
            return true;
        }
#pragma unroll
        for (int ai = 0; ai < 2; ++ai)
#pragma unroll
            for (int m = 0; m < 4; ++m) {
                const size_t ro = (size_t)(row0 + ai * HALF + m * 16) * DM + col0;
#pragma unroll
                for (int bj = 0; bj < 2; ++bj) {
                    const u32x4 gb = *(const u32x4*)(GB + ro + bj * HALF);
                    const float b[8] = {bf_lo(gb.x), bf_hi(gb.x), bf_lo(gb.y), bf_hi(gb.y), bf_lo(gb.z), bf_hi(gb.z), bf_lo(gb.w), bf_hi(gb.w)};
                    float o[8];
#pragma unroll
                    for (int n = 0; n < 2; ++n)
#pragma unroll
                        for (int j = 0; j < 4; ++j) o[4 * n + j] = acc[ai][bj][m][n][j] * b[4 * n + j];
                    u32x4 w; w.x = pk2(o[0], o[1]); w.y = pk2(o[2], o[3]); w.z = pk2(o[4], o[5]); w.w = pk2(o[6], o[7]);
                    *(u32x4*)(MIX + ro + bj * HALF) = w;
                }
            }
        return false;
    }
};

struct EpiP4 {
    static constexpr bool PERM = false, TWICE = false;
    const float *x, *bo; float* out; float* stat;
    __device__ __forceinline__ bool operator()(f32x4 (&acc)[2][2][4][2], const Unit& u, int wr, int wc, int fr, int fq) const {
        const int row0 = u.pm * BM + wr * 64 + fr, col0 = u.pn * BM + wc * 32 + 4 * fq;
        f32x4 bv[2][2];
#pragma unroll
        for (int bj = 0; bj < 2; ++bj)
#pragma unroll
            for (int n = 0; n < 2; ++n) bv[bj][n] = *(const f32x4*)(bo + col0 + bj * HALF + n * 16);
#pragma unroll
        for (int ai = 0; ai < 2; ++ai)
#pragma unroll
            for (int m = 0; m < 4; ++m) {
                const int row = row0 + ai * HALF + m * 16;
                const size_t ro = (size_t)row * DM + col0;
                float s1 = 0.f, s2 = 0.f;
#pragma unroll
                for (int bj = 0; bj < 2; ++bj)
#pragma unroll
                    for (int n = 0; n < 2; ++n) {
                        const f32x4 xv = *(const f32x4*)(x + ro + bj * HALF + n * 16);
                        const f32x4 y = acc[ai][bj][m][n] + bv[bj][n] + ALPHA * xv;
                        *(f32x4*)(out + ro + bj * HALF + n * 16) = y;
                        s1 += (y[0] + y[1]) + (y[2] + y[3]); s2 += (y[0] * y[0] + y[1] * y[1]) + (y[2] * y[2] + y[3] * y[3]);
                    }
                s1 += __shfl_xor(s1, 16); s1 += __shfl_xor(s1, 32); s2 += __shfl_xor(s2, 16); s2 += __shfl_xor(s2, 32);
                if (fq == 0) { __hip_atomic_fetch_add(stat + 2 * row, s1, __ATOMIC_RELAXED, __HIP_MEMORY_SCOPE_AGENT); __hip_atomic_fetch_add(stat + 2 * row + 1, s2, __ATOMIC_RELAXED, __HIP_MEMORY_SCOPE_AGENT); }
            }
        return false;
    }
};

#define XB_TMO      128
#define XB_XCNT(j)  (256  + 64 * (j))
#define XB_XSUB(j)  (1280 + 64 * (j))
#define XB_XGEN(j)  (2304 + 64 * (j))
#define XB_TOP      3328
#define XB_TOPGEN   3392
#define XCD_BAR_WORDS 3456
#define XB_SPIN_CAP (1u << 18)
__device__ __forceinline__ unsigned xb_ld(unsigned* p)              { return __hip_atomic_load(p, __ATOMIC_RELAXED, __HIP_MEMORY_SCOPE_AGENT); }
__device__ __forceinline__ unsigned xb_add(unsigned* p, unsigned v) { return __hip_atomic_fetch_add(p, v, __ATOMIC_RELAXED, __HIP_MEMORY_SCOPE_AGENT); }
__device__ __forceinline__ unsigned xb_xcc_id() { return (unsigned)__builtin_amdgcn_s_getreg((3 << 11) | 20) & 0xFu; }
#define XB_SPIN(cond, bar) do { unsigned _sp = 0; while (cond) { __builtin_amdgcn_s_sleep(1); \
    if ((++_sp & 255u) == 0u) { if (xb_ld(&(bar)[XB_TMO])) break; if (_sp > XB_SPIN_CAP) { atomicAdd(&(bar)[XB_TMO], 1u); break; } } } } while (0)
struct XcdBarrier { unsigned* bar; unsigned x; };
__device__ __forceinline__ XcdBarrier xcd_barrier_post(unsigned* bar) {
    XcdBarrier b; b.bar = bar; b.x = xb_xcc_id();
    if (threadIdx.x == 0) (void)xb_add(&bar[XB_XCNT(b.x)], 1u);
    return b;
}
__device__ __forceinline__ void xcd_barrier_complete(unsigned* bar, unsigned x, unsigned& nloc, unsigned& nx) {
    const unsigned G = gridDim.x * gridDim.y * gridDim.z;
    unsigned sum, cnt, mine, sp = 0u;
    for (;;) {
        sum = 0u; cnt = 0u; mine = 0u;
#pragma unroll
        for (unsigned j = 0; j < 16; ++j) { const unsigned c = xb_ld(&bar[XB_XCNT(j)]); sum += c; cnt += (c > 0u) ? 1u : 0u; mine = (j == x) ? c : mine; }
        if (sum == G) break;
        __builtin_amdgcn_s_sleep(1);
        if ((++sp & 255u) == 0u) { if (xb_ld(&bar[XB_TMO])) break; if (sp > XB_SPIN_CAP) { atomicAdd(&bar[XB_TMO], 1u); break; } }
    }
    nloc = mine > 0u ? mine : 1u; nx = cnt > 0u ? cnt : 1u;
}
__device__ __forceinline__ void xcd_barrier(const XcdBarrier& b) {
    asm volatile("s_waitcnt vmcnt(0)" ::: "memory");
    __syncthreads();
    if (threadIdx.x == 0) {
        unsigned* bar = b.bar;
        __builtin_amdgcn_s_waitcnt(0);
        unsigned* mine = bar + XCD_BAR_WORDS + 2 * blockIdx.x;
        unsigned nloc = mine[0], nx = mine[1];
        if (nloc == 0u) { xcd_barrier_complete(bar, b.x, nloc, nx); mine[0] = nloc; mine[1] = nx; }
        const unsigned old = xb_add(&bar[XB_XSUB(b.x)], 1u);
        const unsigned gen = old / nloc;
        if (old + 1u == (gen + 1u) * nloc) {
            __builtin_amdgcn_fence(__ATOMIC_RELEASE, "agent");
            asm volatile("s_waitcnt vmcnt(0)" ::: "memory");
            const unsigned og = xb_add(&bar[XB_TOP], 1u);
            const unsigned tg = og / nx;
            if (og + 1u == (tg + 1u) * nx) xb_add(&bar[XB_TOPGEN], 1u);
            else XB_SPIN(xb_ld(&bar[XB_TOPGEN]) == tg, bar);
            __builtin_amdgcn_fence(__ATOMIC_ACQUIRE, "agent");
            xb_add(&bar[XB_XGEN(b.x)], 1u);
            asm volatile("s_waitcnt vmcnt(0)" ::: "memory");
        } else {
            XB_SPIN(xb_ld(&bar[XB_XGEN(b.x)]) == gen, bar);
            __builtin_amdgcn_fence(__ATOMIC_ACQUIRE, "agent");
            asm volatile("s_waitcnt vmcnt(0)" ::: "memory");
        }
    }
    __syncthreads();
}

template <bool PERMUTE>
__device__ __forceinline__ void p0_transpose_item(const float* W, int K, int N, bf16_t* WT, LAS float* scr, int item, int lane) {
    const int nblk = N / 32, kb = item / nblk, nb = item % nblk, k0 = 64 * kb, n0 = 32 * nb;
    const int src0 = PERMUTE ? orig_col(n0) : n0;
    float wv[32];
#pragma unroll
    for (int i = 0; i < 32; ++i) wv[i] = W[(size_t)(k0 + 2 * i + (lane >> 5)) * N + src0 + (lane & 31)];
#pragma unroll
    for (int i = 0; i < 32; ++i) scr[(2 * i + (lane >> 5)) * 33 + (lane & 31)] = wv[i];
    asm volatile("s_waitcnt lgkmcnt(0)" ::: "memory");
    const int c = lane & 7;
#pragma unroll
    for (int j = 0; j < 4; ++j) { const int n = (lane >> 3) + 8 * j; const LAS float* s = scr + (8 * c) * 33 + n;
        u32x4 o; o.x = pk2(s[0 * 33], s[1 * 33]); o.y = pk2(s[2 * 33], s[3 * 33]); o.z = pk2(s[4 * 33], s[5 * 33]); o.w = pk2(s[6 * 33], s[7 * 33]);
        *(u32x4*)(WT + (size_t)(n0 + n) * K + k0 + 8 * c) = o; }
    asm volatile("s_waitcnt lgkmcnt(0)" ::: "memory");
}

__device__ __forceinline__ void p0_prologue(const Args& a, LAS unsigned char* lds, int tid, int wave, int lane) {
    unsigned char* ws = a.ws;
    const size_t gt = (size_t)blockIdx.x * 512 + tid, GT = (size_t)gridDim.x * 512;
    LAS float* scr = (LAS float*)(lds + wave * 16384);
    const int gw = blockIdx.x * 8 + wave, NGW = gridDim.x * 8;
    constexpr int I_IN = (DM / 64) * (DIN / 32), I_SQ = (DM / 64) * (DM / 32);
    for (int it = gw; it < I_IN + 3 * I_SQ; it += NGW) {
        int r = it;
        if (r < I_IN) { p0_transpose_item<true>(a.in[1], DM, DIN, (bf16_t*)(ws + WS_WIN), scr, r, lane); continue; } r -= I_IN;
        if (r < I_SQ) { p0_transpose_item<false>(a.in[11], DM, DM, (bf16_t*)(ws + WS_WPA), scr, r, lane); continue; } r -= I_SQ;
        if (r < I_SQ) { p0_transpose_item<false>(a.in[12], DM, DM, (bf16_t*)(ws + WS_WPB), scr, r, lane); continue; } r -= I_SQ;
        p0_transpose_item<false>(a.in[13], DM, DM, (bf16_t*)(ws + WS_WO), scr, r, lane);
    }
    if (gt < 8 * 128 * 128) { const int t = (int)(gt >> 7) & 127, s = (int)gt & 127; const float w = a.in[9][gt]; ((bf16_t*)(ws + WS_WS))[gt] = (s <= t) ? (bf16_t)(pk2(w, 0.f) & 0xffffu) : (bf16_t)0; }
    if (gt < DIN) ((float*)(ws + WS_BIAS))[gt] = a.in[2][orig_col((int)gt)];
    if (gt < 2 * NTOK) { ((float*)(ws + WS_STAT))[gt] = 0.f; ((float*)(ws + WS_VSTAT))[gt] = 0.f; }
    const f32x4* x4 = (const f32x4*)a.in[0]; u32x4* xb = (u32x4*)(ws + WS_XB);
    constexpr size_t NX = (size_t)NTOK * DM / 8;
    size_t i = gt;
    for (; i + 3 * GT < NX; i += 4 * GT) {
        f32x4 p[4], q[4];
#pragma unroll
        for (int k = 0; k < 4; ++k) { p[k] = __builtin_nontemporal_load(x4 + 2 * (i + k * GT)); q[k] = __builtin_nontemporal_load(x4 + 2 * (i + k * GT) + 1); }
#pragma unroll
        for (int k = 0; k < 4; ++k) { u32x4 o; o.x = pk2(p[k][0], p[k][1]); o.y = pk2(p[k][2], p[k][3]); o.z = pk2(q[k][0], q[k][1]); o.w = pk2(q[k][2], q[k][3]); xb[i + k * GT] = o; }
    }
    for (; i < NX; i += GT) {
        const f32x4 p = x4[2 * i], q = x4[2 * i + 1];
        u32x4 o; o.x = pk2(p[0], p[1]); o.y = pk2(p[2], p[3]); o.z = pk2(q[0], q[1]); o.w = pk2(q[2], q[3]);
        xb[i] = o;
    }
}


template <int O, int N> __device__ __forceinline__ void tr_step(float (&v)[32], int lane) {
    const bool up = (lane & O) != 0;
#pragma unroll
    for (int i = 0; i < N; ++i) { const float send = up ? v[i] : v[i + N]; const float keep = up ? v[i + N] : v[i]; v[i] = keep + __shfl_xor(send, O); }
}
__device__ __forceinline__ float tr_reduce32(float (&v)[32], int lane) {
    tr_step<32, 16>(v, lane); tr_step<16, 8>(v, lane); tr_step<8, 4>(v, lane); tr_step<4, 2>(v, lane); tr_step<2, 1>(v, lane);
    return v[0] + __shfl_xor(v[0], 1);
}

__device__ __forceinline__ void p2_conv_item(const bf16_t* H, bf16_t* SA, const float* conv_w, f32x2 cb, f32x2 gg, f32x2 gb, long R0, int t0, int c, bool has_prev, int lane) {
    f32x2 w[31];
#pragma unroll
    for (int j = 0; j < 31; ++j) w[j] = *(const f32x2*)(conv_w + j * DM + c);
    f32x2 acc[16];
#pragma unroll
    for (int t = 0; t < 16; ++t) acc[t] = cb;
#pragma unroll
    for (int ib = 0; ib < 46; ib += 12) {
        unsigned raw[12];
#pragma unroll
        for (int k = 0; k < 12; ++k) { const int idx = ib + k, tok = t0 - 30 + idx; raw[k] = 0u;
            if (idx < 46 && (tok >= 0 || has_prev)) raw[k] = *(const unsigned*)(H + (R0 + tok) * DM + c); }
        asm volatile("" ::: "memory");
#pragma unroll
        for (int k = 0; k < 12; ++k) { const int idx = ib + k; const f32x2 hv = {bf_lo(raw[k]), bf_hi(raw[k])};
#pragma unroll
            for (int t = 0; t < 16; ++t) { const int j = idx - t; if (idx < 46 && j >= 0 && j <= 30) acc[t] += w[j] * hv; } }
    }
    float q[32];
#pragma unroll
    for (int t = 0; t < 16; ++t) { q[2 * t] = acc[t].x + acc[t].y; q[2 * t + 1] = acc[t].x * acc[t].x + acc[t].y * acc[t].y; }
    asm volatile("" ::: "memory");
    const float tot = tr_reduce32(q, lane);
    const float oth = __shfl_xor(tot, 2);
    const bool issq = (lane & 2) != 0;
    const float s1 = issq ? oth : tot, s2 = issq ? tot : oth;
    const float mean = s1 * (1.f / 128.f), var = fmaxf(s2 * (1.f / 128.f) - mean * mean, 0.f), rstd = __builtin_amdgcn_rsqf(var + LN_EPS);
    unsigned sraw[16];
#pragma unroll
    for (int t = 0; t < 16; ++t) sraw[t] = *(const unsigned*)(SA + (R0 + t0 + t) * DM + c);
#pragma unroll
    for (int t = 0; t < 16; ++t) {
        const float mt = __int_as_float(__builtin_amdgcn_readlane(__float_as_int(mean), 4 * t)), rt = __int_as_float(__builtin_amdgcn_readlane(__float_as_int(rstd), 4 * t));
        const float y0 = (acc[t].x - mt) * rt * gg.x + gb.x, y1 = (acc[t].y - mt) * rt * gg.y + gb.y;
        *(unsigned*)(SA + (R0 + t0 + t) * DM + c) = pk2(fsilu(y0) * bf_lo(sraw[t]), fsilu(y1) * bf_hi(sraw[t]));
    }
}

__device__ __forceinline__ void p2_conv(const Args& a, int chunk, int cw  , int lane) {
    const bf16_t* H = (const bf16_t*)(a.ws + WS_H); bf16_t* SA = (bf16_t*)(a.ws + WS_SA);
    const float *conv_w = a.in[3], *conv_b = a.in[4], *gn_g = a.in[5], *gn_b = a.in[6];
    const bool has_prev = (chunk & 15) != 0;
    const long R0 = (long)chunk * 128;
#pragma unroll 1
    for (int it = 0; it < 16; ++it) {
        const int g = it >> 1, sl = cw + 4 * (it & 1);
        const int c = g * 128 + 2 * lane;
        const f32x2 cb = *(const f32x2*)(conv_b + c), gg = *(const f32x2*)(gn_g + c), gb = *(const f32x2*)(gn_b + c);
        p2_conv_item(H, SA, conv_w, cb, gg, gb, R0, sl * 16, c, has_prev, lane);
    }
}

__device__ __forceinline__ void p2_gmlp(const Args& a, LAS unsigned char* lds, int chunk, int gw  , int lane) {
    const bf16_t* V = (const bf16_t*)(a.ws + WS_V); bf16_t* UB = (bf16_t*)(a.ws + WS_UB); const bf16_t* WsB = (const bf16_t*)(a.ws + WS_WS);
    const float* vstat = (const float*)(a.ws + WS_VSTAT);
    const float *ln_g = a.in[7], *ln_b = a.in[8], *b_sp = a.in[10];
    LAS unsigned char* vt = lds + gw * 32768;
    LAS f32x2* st = (LAS f32x2*)(lds + 4 * 32768 + gw * 1024);
    const long R0 = (long)chunk * 128;
    const int fr = lane & 15, fq = lane >> 4;
#pragma unroll
    for (int k = 0; k < 2; ++k) { const int t = lane + 64 * k; const f32x2 sv = *(const f32x2*)(vstat + 2 * (R0 + t));
        const float mean = sv.x * (1.f / 1024.f), var = fmaxf(sv.y * (1.f / 1024.f) - mean * mean, 0.f), rstd = __builtin_amdgcn_rsqf(var + LN_EPS);
        st[t] = (f32x2){rstd, -mean * rstd}; }
#pragma unroll 1
    for (int hh = 0; hh < 2; ++hh) {
        const int h = 2 * gw + hh;
        const int d8 = lane & 15, sq = lane >> 4;
        const f32x4 g0 = *(const f32x4*)(ln_g + h * 128 + d8 * 8), g1 = *(const f32x4*)(ln_g + h * 128 + d8 * 8 + 4);
        const f32x4 e0 = *(const f32x4*)(ln_b + h * 128 + d8 * 8), e1 = *(const f32x4*)(ln_b + h * 128 + d8 * 8 + 4);
        const float gk[8] = {g0[0], g0[1], g0[2], g0[3], g1[0], g1[1], g1[2], g1[3]}, ek[8] = {e0[0], e0[1], e0[2], e0[3], e1[0], e1[1], e1[2], e1[3]};
#pragma unroll 1
        for (int it = 0; it < 4; ++it) {
            const int sg = it * 4 + sq;
            u32x4 raw[8];
#pragma unroll
            for (int e = 0; e < 8; ++e) raw[e] = *(const u32x4*)(V + (R0 + sg * 8 + e) * DM + h * 128 + d8 * 8);
            float val[8][8];
#pragma unroll
            for (int e = 0; e < 8; ++e) { const f32x2 sc = st[sg * 8 + e];
#pragma unroll
                for (int k = 0; k < 4; ++k) { val[e][2 * k] = (bf_lo(raw[e][k]) * sc.x + sc.y) * gk[2 * k] + ek[2 * k]; val[e][2 * k + 1] = (bf_hi(raw[e][k]) * sc.x + sc.y) * gk[2 * k + 1] + ek[2 * k + 1]; } }
#pragma unroll
            for (int k = 0; k < 8; ++k) { const int d = d8 * 8 + k;
                u32x4 o; o.x = pk2(val[0][k], val[1][k]); o.y = pk2(val[2][k], val[3][k]); o.z = pk2(val[4][k], val[5][k]); o.w = pk2(val[6][k], val[7][k]);
                *(LAS u32x4*)(vt + d * 256 + ((sg + d + (d >> 3)) & 15) * 16) = o; }
        }
#pragma unroll 1
        for (int tb = 0; tb < 4; ++tb) {
            f32x4 acc[2][8];
#pragma unroll
            for (int mi = 0; mi < 2; ++mi)
#pragma unroll
                for (int ni = 0; ni < 8; ++ni) acc[mi][ni] = (f32x4){0.f, 0.f, 0.f, 0.f};
            for (int ks = 0; ks <= tb; ++ks) {
                bf16x8 wf[2], vf[8];
#pragma unroll
                for (int mi = 0; mi < 2; ++mi) wf[mi] = *(const bf16x8*)(WsB + (size_t)((h * 128 + 32 * tb + 16 * mi + fr) * 128 + ks * 32 + fq * 8));
#pragma unroll
                for (int ni = 0; ni < 8; ++ni) { const int dd = 16 * ni + fr; vf[ni] = *(const LAS bf16x8*)(vt + dd * 256 + (((ks * 4 + fq) + dd + (dd >> 3)) & 15) * 16); }
#pragma unroll
                for (int mi = 0; mi < 2; ++mi)
#pragma unroll
                    for (int ni = 0; ni < 8; ++ni) acc[mi][ni] = __builtin_amdgcn_mfma_f32_16x16x32_bf16(vf[ni], wf[mi], acc[mi][ni], 0, 0, 0);
            }
#pragma unroll
            for (int mi = 0; mi < 2; ++mi) {
                const int t = 32 * tb + 16 * mi + fr;
                const float bsp = b_sp[h * 128 + t];
                u32x2* prow = (u32x2*)(UB + (R0 + t) * DM + h * 128 + 4 * fq);
                u32x2 ub[8];
#pragma unroll
                for (int ni = 0; ni < 8; ++ni) ub[ni] = prow[4 * ni];
#pragma unroll
                for (int ni = 0; ni < 8; ++ni) {
                    u32x2 o; o.x = pk2((acc[mi][ni][0] + bsp) * bf_lo(ub[ni].x), (acc[mi][ni][1] + bsp) * bf_hi(ub[ni].x));
                    o.y = pk2((acc[mi][ni][2] + bsp) * bf_lo(ub[ni].y), (acc[mi][ni][3] + bsp) * bf_hi(ub[ni].y));
                    prow[4 * ni] = o;
                }
            }
        }
    }
}

__device__ __forceinline__ void p5_ln(const Args& a, int wave, int lane) {
    const float* stat = (const float*)(a.ws + WS_STAT);
    const f32x4* g4 = (const f32x4*)a.in[15]; const f32x4* b4 = (const f32x4*)a.in[16];
    f32x4 gg[4], bb[4];
#pragma unroll
    for (int j = 0; j < 4; ++j) { gg[j] = g4[lane + 64 * j]; bb[j] = b4[lane + 64 * j]; }
    for (int row = blockIdx.x * 8 + wave; row < NTOK; row += gridDim.x * 8) {
        const float s1 = stat[2 * row], s2 = stat[2 * row + 1];
        const float mean = s1 * (1.f / 1024.f), var = fmaxf(s2 * (1.f / 1024.f) - mean * mean, 0.f), rstd = __builtin_amdgcn_rsqf(var + LN_EPS);
        f32x4* p = (f32x4*)(a.out + (size_t)row * DM) + lane;
        f32x4 v[4];
#pragma unroll
        for (int j = 0; j < 4; ++j) v[j] = p[64 * j];
#pragma unroll
        for (int j = 0; j < 4; ++j) p[64 * j] = (v[j] - mean) * rstd * gg[j] + bb[j];
    }
}

__global__ void __launch_bounds__(512) fwd_megakernel(Args a) {
    extern __shared__ __attribute__((aligned(16))) unsigned char lds_raw[];
    LAS unsigned char* lds = (LAS unsigned char*)lds_raw;
    const int tid = threadIdx.x, lane = tid & 63, wave = __builtin_amdgcn_readfirstlane(tid >> 6);
    const int G = gridDim.x, c = blockIdx.x;
    unsigned char* ws = a.ws;
    const int lo = a.ph_lo, hi = a.ph_hi;
#define IN(k) (lo <= (k) && (k) < hi)
#ifdef PROBE_PHASE
    unsigned long long tstamp[7]; int nst = 0;
#define STAMP() do { tstamp[nst++] = __builtin_amdgcn_s_memrealtime(); } while (0)
#else
#define STAMP() do {} while (0)
#endif
    const XcdBarrier gbar = xcd_barrier_post((unsigned*)(a.ws + WS_CTL));
#define SEAM(k) do { if (IN(k) && IN((k) + 1)) xcd_barrier(gbar); STAMP(); } while (0)
    STAMP();

    if (IN(0)) { p0_prologue(a, lds, tid, wave, lane); }
    SEAM(0);
    if (IN(1)) {
        SchedSimple S{(const char*)(ws + WS_XB), (const char*)(ws + WS_WIN), NTOK / BM, DIN / BM, G, c};
        LAS float* lbias = (LAS float*)(lds + BIAS_OFF);
        for (int i = tid; i < DIN; i += 512) lbias[i] = a.in[2][orig_col(i)];
        __syncthreads();
        EpiP1 E{lbias, ws};
        gemm_phase(lds, S, E);
    }
    SEAM(1);
    if (IN(2)) {
        for (int chunk = c; chunk < NTOK / 128; chunk += G) { if (wave < 4) p2_gmlp(a, lds, chunk, wave, lane); else p2_conv(a, chunk, wave - 4, lane); }
    }
    SEAM(2);
    if (IN(3)) {
        SchedDual S{(const char*)(ws + WS_SA), (const char*)(ws + WS_WPA), (const char*)(ws + WS_UB), (const char*)(ws + WS_WPB), NTOK / BM, DM / BM, G, c};
        EpiP3 E{(const bf16_t*)(ws + WS_GA), (const bf16_t*)(ws + WS_GB), (bf16_t*)(ws + WS_MIX)};
        gemm_phase(lds, S, E);
    }
    SEAM(3);
    if (IN(4)) {
        SchedSimple S{(const char*)(ws + WS_MIX), (const char*)(ws + WS_WO), NTOK / BM, DM / BM, G, c};
        EpiP4 E{a.in[0], a.in[14], a.out, (float*)(ws + WS_STAT)};
        gemm_phase(lds, S, E);
    }
    SEAM(4);
    if (IN(5)) { p5_ln(a, wave, lane); }
#ifdef PROBE_PHASE
    STAMP();
    if (c == 0 && tid == 0) a.out[0] += (float)(tstamp[PROBE_PHASE + 1] - tstamp[PROBE_PHASE]) * 0.01f;
#endif
}

extern "C" void kernel_launch(void* const* d_in, const int* in_sizes, int n_in, void* d_out, int out_size, void* d_ws, size_t ws_size, hipStream_t stream) {
    static int grid = 0;
    if (grid == 0) {
        if (n_in != 17 || in_sizes[0] != NTOK * DM || out_size != NTOK * DM || ws_size < WS_END) {
            fprintf(stderr, "kernel_launch: unexpected shapes (n_in %d, in0 %d, out %d, ws %zu < %zu); nothing launched\n", n_in, n_in > 0 ? in_sizes[0] : -1, out_size, ws_size, (size_t)WS_END); grid = -1; return; }
        int dev = 0, cus = 0, per_cu = 0;
        (void)hipGetDevice(&dev);
        (void)hipDeviceGetAttribute(&cus, hipDeviceAttributeMultiprocessorCount, dev);
        if (hipFuncSetAttribute((const void*)fwd_megakernel, hipFuncAttributeMaxDynamicSharedMemorySize, LDS_BYTES) != hipSuccess) { fprintf(stderr, "kernel_launch: hipFuncSetAttribute failed\n"); grid = -1; return; }
        if (hipOccupancyMaxActiveBlocksPerMultiprocessor(&per_cu, (const void*)fwd_megakernel, 512, LDS_BYTES) != hipSuccess || per_cu < 1) { fprintf(stderr, "kernel_launch: occupancy query failed (%d)\n", per_cu); (void)hipGetLastError(); per_cu = 1; }
        if (per_cu > 1) per_cu = 1;
        grid = cus * per_cu;
    }
    if (grid < 0) return;
    if (hipMemsetAsync((char*)d_ws + WS_CTL, 0, CTL_BYTES, stream) != hipSuccess) { fprintf(stderr, "kernel_launch: hipMemsetAsync of the barrier words failed\n"); return; }
    Args a{};
    for (int i = 0; i < 17; ++i) a.in[i] = (const float*)d_in[i];
    a.out = (float*)d_out; a.ws = (unsigned char*)d_ws;
#if N_LAUNCHES == 1
    a.ph_lo = 0; a.ph_hi = 6;
    void* args[] = {&a};
    hipError_t e = hipLaunchCooperativeKernel((const void*)fwd_megakernel, dim3(grid), dim3(512), args, LDS_BYTES, stream);
    if (e != hipSuccess) fprintf(stderr, "cooperative launch failed: %s (grid %d)\n", hipGetErrorString(e), grid);
#else
    for (int ph = 0; ph < 6; ++ph) {
        a.ph_lo = ph; a.ph_hi = ph + 1;
        hipLaunchKernelGGL(fwd_megakernel, dim3(grid), dim3(512), LDS_BYTES, stream, a);
    }
#endif
}
```

```cpp
#include <hip/hip_runtime.h>
#include <hip/hip_cooperative_groups.h>
#include <cstdio>
#include <cstdint>
namespace cg = cooperative_groups;

#ifndef N_LAUNCHES
#define N_LAUNCHES 1
#endif

#define LAS __attribute__((address_space(3)))
typedef unsigned short bf16_t;
typedef short bf16x8 __attribute__((ext_vector_type(8)));
typedef float f32x4 __attribute__((ext_vector_type(4)));
typedef float f32x2 __attribute__((ext_vector_type(2)));
typedef unsigned u32x4 __attribute__((ext_vector_type(4)));
typedef unsigned u32x2 __attribute__((ext_vector_type(2)));

constexpr int DM = 1024, NTOK = 32768, DIN = 8192;
constexpr float LN_EPS = 1e-5f;
constexpr float ALPHA = 1.189207115002721f;
constexpr int BM = 256, BK = 64, HALF = 128, HTB = HALF * BK * 2, STAGE_BYTES = 8 * HTB, WGM = 8;
constexpr int BIAS_OFF = STAGE_BYTES;
constexpr int LDS_BYTES = STAGE_BYTES + DIN * 4;
constexpr int KDIM = 1024;

constexpr size_t MiB = (size_t)1 << 20;
constexpr size_t WS_XB = 0, WS_H = 64 * MiB, WS_SA = 128 * MiB, WS_UB = 192 * MiB, WS_V = 256 * MiB, WS_GA = 320 * MiB, WS_GB = 384 * MiB;
constexpr size_t WS_WIN = 448 * MiB, WS_WPA = 464 * MiB, WS_WPB = 466 * MiB, WS_WO = 468 * MiB, WS_WS = 470 * MiB;
constexpr size_t WS_BIAS = WS_WS + 256 * 1024, WS_STAT = WS_BIAS + 256 * 1024, WS_VSTAT = WS_STAT + 256 * 1024, WS_CTL = 471 * MiB, WS_END = 472 * MiB;
constexpr size_t WS_MIX = WS_XB;
constexpr size_t CTL_BYTES = 32768;

struct Args {
    const float* in[17];
    float* out;
    unsigned char* ws;
    int ph_lo, ph_hi;
};

typedef __bf16 bf16x2_t __attribute__((ext_vector_type(2)));
__device__ __forceinline__ unsigned pk2(float lo, float hi) { const f32x2 v = {lo, hi}; return __builtin_bit_cast(unsigned, __builtin_convertvector(v, bf16x2_t)); }
__device__ __forceinline__ float bf_lo(unsigned u) { return __uint_as_float(u << 16); }
__device__ __forceinline__ float bf_hi(unsigned u) { return __uint_as_float(u & 0xffff0000u); }
#ifdef PROBE_NOACT
__device__ __forceinline__ float fsigmoid(float x) { return 0.5f + 0.01f * x; }
__device__ __forceinline__ float fsigmoid_unused(float x) {
#else
__device__ __forceinline__ float fsigmoid(float x) {
#endif
    return __builtin_amdgcn_rcpf(1.0f + __builtin_amdgcn_exp2f(-1.4426950408889634f * x)); }
__device__ __forceinline__ float fsilu(float x) { return x * fsigmoid(x); }
__device__ __forceinline__ float fgelu(float x) { return x * fsigmoid(1.5957691216057308f * (x + 0.044715f * x * x * x)); }
__device__ __forceinline__ float wave_sum(float v) {
#pragma unroll
    for (int o = 1; o < 64; o <<= 1) v += __shfl_xor(v, o);
    return v;
}
__host__ __device__ __forceinline__ int orig_col(int p) {
    const int tile = p >> 8, q = p & 255;
    if (tile < 8) return (q < 128) ? tile * 128 + q : 1024 + tile * 128 + (q - 128);
    if (tile < 16) { const int tt = tile - 8; return (q < 128) ? 3072 + tt * 128 + q : 5120 + tt * 128 + (q - 128); }
    if (tile < 20) return 2048 + (tile - 16) * 256 + q;
    if (tile < 24) return 4096 + (tile - 20) * 256 + q;
    if (tile < 28) return 6144 + (tile - 24) * 256 + q;
    return 7168 + (tile - 28) * 256 + q;
}

__host__ __device__ __forceinline__ int lds_byte(int r, int c) { const int st = (r >> 4) * 2 + (c >> 5), rr = r & 15, cc = c & 31, ob = rr * 64 + cc * 2; return st * 1024 + (ob ^ (((ob >> 9) & 1) << 5)); }
__host__ __device__ __forceinline__ void stage_rc(int b, int& R, int& C) { const int st = b / 1024, sb = b % 1024, swz = sb ^ (((sb >> 9) & 1) << 5); R = (st >> 1) * 16 + swz / 64; C = (st & 1) * 32 + (swz % 64) / 2; }
__host__ __device__ __forceinline__ int perm32(int rho) { const int n = rho >> 4, i = rho & 15; return 8 * (i >> 2) + 4 * n + (i & 3); }

struct Unit { const char* A; const char* B; int pm, pn, kind; };

__device__ __forceinline__ bool tile_order(long L, int nM, int nN, int& pm, int& pn) {
    const int nwg = nM * nN; if (L >= nwg) return false;
    int wgid = (int)L; { const int q = nwg / 8, r = nwg % 8, xcd = wgid % 8, off = wgid / 8; wgid = (xcd < r ? xcd * (q + 1) : r * (q + 1) + (xcd - r) * q) + off; }
    const int nig = WGM * nN, gid = wgid / nig, fm = gid * WGM, gsz = (nM - fm) < WGM ? (nM - fm) : WGM;
    pm = fm + ((wgid % nig) % gsz); pn = (wgid % nig) / gsz; return true;
}
constexpr size_t TSTEP = (size_t)BM * KDIM * 2;

struct SchedSimple {
    const char* A; const char* B; int nM, nN, G, c;
    __device__ __forceinline__ bool next(int i, Unit& u) const {
        if (!tile_order((long)i * G + c, nM, nN, u.pm, u.pn)) return false;
        u.A = A + (size_t)u.pm * TSTEP; u.B = B + (size_t)u.pn * TSTEP; u.kind = 1; return true;
    }
};
struct SchedDual {
    const char *A0, *B0, *A1, *B1; int nM, nN, G, c;
    __device__ __forceinline__ bool next(int i, Unit& u) const {
        if (!tile_order((long)(i >> 1) * G + c, nM, nN, u.pm, u.pn)) return false;
        u.kind = i & 1;
        u.A = (u.kind ? A1 : A0) + (size_t)u.pm * TSTEP; u.B = (u.kind ? B1 : B0) + (size_t)u.pn * TSTEP; return true;
    }
};

template <class Epi, class Sched>
__device__ __forceinline__ void gemm_phase(LAS unsigned char* lds, const Sched& S, const Epi& E) {
    const int tid = threadIdx.x, wid = __builtin_amdgcn_readfirstlane(tid >> 6), lane = tid & 63, wr = wid >> 2, wc = wid & 3, fr = lane & 15, fq = lane >> 4;
    constexpr int K = KDIM, nt = K / BK;
    unsigned voffA[2], voffB[2];
#pragma unroll
    for (int i = 0; i < 2; ++i) { int R, C; stage_rc(tid * 16 + i * 8192, R, C); const int Rb = Epi::PERM ? ((R & ~31) + perm32(R & 31)) : R;
        voffA[i] = (unsigned)(R * K + C) * 2u; voffB[i] = (unsigned)(Rb * K + C) * 2u; }
    constexpr size_t kstep = (size_t)(BK * 2);
    constexpr size_t hstep = (size_t)HALF * K * 2;
    const unsigned ldsw = (unsigned)wid * 1024u;
    const int aoff = lds_byte(wr * 64 + fr, fq * 8), boff = lds_byte(wc * 32 + fr, fq * 8);
#define PG8_SA(b, h) (((b) * 2 + (h)) * HTB)
#define PG8_SB(b, h) ((4 + (b) * 2 + (h)) * HTB)
#define PG8_STAGE(bufoff, gbase, voff) do { _Pragma("unroll") for (int _i = 0; _i < 2; ++_i) \
        __builtin_amdgcn_global_load_lds((const unsigned*)((const char*)(gbase) + (voff)[_i]), (LAS unsigned*)(lds + (bufoff) + ldsw + _i * 8192), 16, 0, 0); } while (0)
#define PG8_LDA(dst, b, h) do { _Pragma("unroll") for (int m = 0; m < 4; ++m) _Pragma("unroll") for (int k = 0; k < 2; ++k) dst[m][k] = *(const LAS bf16x8*)(lds + PG8_SA(b, h) + aoff + m * 2048 + k * 1024); } while (0)
#define PG8_LDB(dst, b, h) do { _Pragma("unroll") for (int n = 0; n < 2; ++n) _Pragma("unroll") for (int k = 0; k < 2; ++k) dst[n][k] = *(const LAS bf16x8*)(lds + PG8_SB(b, h) + boff + n * 2048 + k * 1024); } while (0)
#define PG8_MMA(ai, bj, At, Bt) do { __builtin_amdgcn_s_setprio(1); _Pragma("unroll") for (int m = 0; m < 4; ++m) _Pragma("unroll") for (int n = 0; n < 2; ++n) _Pragma("unroll") for (int k = 0; k < 2; ++k) \
        acc[ai][bj][m][n] = __builtin_amdgcn_mfma_f32_16x16x32_bf16(Bt[n][k], At[m][k], acc[ai][bj][m][n], 0, 0, 0); __builtin_amdgcn_s_setprio(0); } while (0)
#define PG8_WAIT_V(n) asm volatile("s_waitcnt vmcnt(" #n ")" ::: "memory")
#define PG8_WAIT_L(n) asm volatile("s_waitcnt lgkmcnt(" #n ")" ::: "memory")
#define PG8_BAR __builtin_amdgcn_s_barrier()
#define PG8_SCHED __builtin_amdgcn_sched_barrier(0)
    Unit cur, nxt; int ui = 0;
    if (!S.next(0, cur)) return;
    f32x4 acc[2][2][4][2];
#pragma unroll
    for (int a = 0; a < 2; ++a)
#pragma unroll
        for (int b = 0; b < 2; ++b)
#pragma unroll
            for (int m = 0; m < 4; ++m)
#pragma unroll
                for (int n = 0; n < 2; ++n) acc[a][b][m][n] = (f32x4){0.f, 0.f, 0.f, 0.f};
    bf16x8 At[4][2], B0[2][2], B1[2][2];
    const char* cA = cur.A; const char* cB = cur.B;
    PG8_STAGE(PG8_SB(0, 0), cB, voffB); PG8_STAGE(PG8_SB(0, 1), cB + hstep, voffB); PG8_STAGE(PG8_SA(0, 0), cA, voffA); PG8_STAGE(PG8_SA(0, 1), cA + hstep, voffA);
    if (wr == 1) PG8_BAR;
    PG8_WAIT_V(2); PG8_BAR;
    PG8_STAGE(PG8_SB(1, 0), cB + kstep, voffB); PG8_STAGE(PG8_SA(1, 0), cA + kstep, voffA); PG8_STAGE(PG8_SB(1, 1), cB + hstep + kstep, voffB);
    PG8_WAIT_V(6); PG8_BAR;
    for (;;) {
        const bool has_next = S.next(ui + 1, nxt);
        const char* nA = has_next ? nxt.A : cA; const char* nB = has_next ? nxt.B : cB;
        for (int t = 0; t < nt; t += 2) {
            const bool last = (t == nt - 2);
            const char* a1 = cA + (size_t)(t + 1) * kstep;
            const char* a2 = last ? nA : cA + (size_t)(t + 2) * kstep; const char* b2 = last ? nB : cB + (size_t)(t + 2) * kstep;
            const char* a3 = a2 + kstep; const char* b3 = b2 + kstep;
            PG8_LDB(B0, 0, 0); PG8_LDB(B1, 0, 1); PG8_SCHED; PG8_LDA(At, 0, 0); PG8_STAGE(PG8_SA(1, 1), a1 + hstep, voffA);
            PG8_WAIT_V(8); PG8_WAIT_L(0); PG8_BAR; PG8_MMA(0, 0, At, B0); PG8_MMA(0, 1, At, B1); PG8_BAR; PG8_SCHED;
            PG8_LDA(At, 0, 1); PG8_STAGE(PG8_SB(0, 0), b2, voffB); PG8_STAGE(PG8_SB(0, 1), b2 + hstep, voffB); PG8_STAGE(PG8_SA(0, 0), a2, voffA);
            PG8_WAIT_V(8); PG8_WAIT_L(0); PG8_BAR; PG8_MMA(1, 0, At, B0); PG8_MMA(1, 1, At, B1); PG8_BAR; PG8_SCHED;
            PG8_LDB(B0, 1, 0); PG8_LDB(B1, 1, 1); PG8_SCHED; PG8_LDA(At, 1, 0); PG8_STAGE(PG8_SA(0, 1), a2 + hstep, voffA);
            PG8_WAIT_V(8); PG8_WAIT_L(0); PG8_BAR; PG8_MMA(0, 0, At, B0); PG8_MMA(0, 1, At, B1); PG8_BAR; PG8_SCHED;
            PG8_LDA(At, 1, 1); PG8_STAGE(PG8_SB(1, 0), b3, voffB); PG8_STAGE(PG8_SB(1, 1), b3 + hstep, voffB); PG8_STAGE(PG8_SA(1, 0), a3, voffA);
            PG8_WAIT_V(8); PG8_WAIT_L(0); PG8_BAR; PG8_MMA(1, 0, At, B0); PG8_MMA(1, 1, At, B1); PG8_BAR; PG8_SCHED;
        }
        if (wr == 0) PG8_BAR;
#ifdef PROBE_EPI2X
        if (Epi::TWICE) { E(acc, cur, wr, wc, fr, fq);
            _Pragma("unroll") for (int a = 0; a < 2; ++a) _Pragma("unroll") for (int b = 0; b < 2; ++b) _Pragma("unroll") for (int m = 0; m < 4; ++m) _Pragma("unroll") for (int n = 0; n < 2; ++n) asm volatile("" : "+v"(acc[a][b][m][n]) :: "memory"); }
#endif
        const bool keep = E(acc, cur, wr, wc, fr, fq);
        if (!has_next) break;
        if (!keep) {
#pragma unroll
            for (int a = 0; a < 2; ++a)
#pragma unroll
                for (int b = 0; b < 2; ++b)
#pragma unroll
                    for (int m = 0; m < 4; ++m)
#pragma unroll
                        for (int n = 0; n < 2; ++n) acc[a][b][m][n] = (f32x4){0.f, 0.f, 0.f, 0.f};
        }
        cur = nxt; cA = nA; cB = nB; ++ui;
        if (wr == 1) PG8_BAR;
    }
    PG8_WAIT_V(0);
    PG8_BAR;
#undef PG8_SA
#undef PG8_SB
#undef PG8_STAGE
#undef PG8_LDA
#undef PG8_LDB
#undef PG8_MMA
#undef PG8_WAIT_V
#undef PG8_WAIT_L
#undef PG8_BAR
#undef PG8_SCHED
}

template <int T> __device__ __forceinline__ float act1(float a) { return T == 0 ? fsilu(a) : T == 1 ? fgelu(a) : fsigmoid(a); }
template <int T  > __device__ __forceinline__ void epi_pair(const f32x4 (&acc)[2][2][4][2], const f32x4 (&bv)[2][2], bf16_t* O, int row0) {
#pragma unroll
    for (int ai = 0; ai < 2; ++ai)
#pragma unroll
        for (int m = 0; m < 4; ++m) {
            bf16_t* rowp = O + (size_t)(row0 + ai * HALF + m * 16) * DM;
            float o[8];
#pragma unroll
            for (int n = 0; n < 2; ++n) { const f32x4 a = acc[ai][0][m][n] + bv[0][n], g = acc[ai][1][m][n] + bv[1][n];
#pragma unroll
                for (int j = 0; j < 4; ++j) {
                    if (T == 0) o[4 * n + j] = a[j] * fsigmoid(g[j]);
                    else {
                        const float ea = __builtin_amdgcn_exp2f(-1.4426950408889634f * 1.5957691216057308f * (a[j] + 0.044715f * a[j] * a[j] * a[j]));
                        const float eg = __builtin_amdgcn_exp2f(-1.4426950408889634f * g[j]);
                        o[4 * n + j] = a[j] * g[j] * __builtin_amdgcn_rcpf((1.0f + ea) * (1.0f + eg));
                    } } }
            u32x4 w; w.x = pk2(o[0], o[1]); w.y = pk2(o[2], o[3]); w.z = pk2(o[4], o[5]); w.w = pk2(o[6], o[7]);
            *(u32x4*)rowp = w;
        }
}
template <int T  > __device__ __forceinline__ void epi_solo(const f32x4 (&acc)[2][2][4][2], const f32x4 (&bv)[2][2], bf16_t* O, int row0, float* vstat, int fq) {
#pragma unroll
    for (int ai = 0; ai < 2; ++ai)
#pragma unroll
        for (int m = 0; m < 4; ++m) {
            const int row = row0 + ai * HALF + m * 16;
            bf16_t* rowp = O + (size_t)row * DM;
            float s1 = 0.f, s2 = 0.f;
#pragma unroll
            for (int bj = 0; bj < 2; ++bj) {
                float o[8];
#pragma unroll
                for (int n = 0; n < 2; ++n) { const f32x4 a = acc[ai][bj][m][n] + bv[bj][n];
#pragma unroll
                    for (int j = 0; j < 4; ++j) { o[4 * n + j] = act1<T>(a[j]); if (T == 1) { s1 += o[4 * n + j]; s2 += o[4 * n + j] * o[4 * n + j]; } } }
                u32x4 w; w.x = pk2(o[0], o[1]); w.y = pk2(o[2], o[3]); w.z = pk2(o[4], o[5]); w.w = pk2(o[6], o[7]);
                *(u32x4*)(rowp + bj * HALF) = w;
            }
            if (T == 1) {
                s1 += __shfl_xor(s1, 16); s1 += __shfl_xor(s1, 32); s2 += __shfl_xor(s2, 16); s2 += __shfl_xor(s2, 32);
                if (fq == 0) { __hip_atomic_fetch_add(vstat + 2 * row, s1, __ATOMIC_RELAXED, __HIP_MEMORY_SCOPE_AGENT); __hip_atomic_fetch_add(vstat + 2 * row + 1, s2, __ATOMIC_RELAXED, __HIP_MEMORY_SCOPE_AGENT); }
            }
        }
}
struct EpiP1 {
    static constexpr bool PERM = true, TWICE = true;
    const LAS float* biasP; unsigned char* ws;
    __device__ __forceinline__ bool operator()(f32x4 (&acc)[2][2][4][2], const Unit& u, int wr, int wc, int fr, int fq) const {
        const int tile = u.pn;
        const int row0 = u.pm * BM + wr * 64 + fr, qc = wc * 32 + 8 * fq;
        f32x4 bv[2][2];
#pragma unroll
        for (int bj = 0; bj < 2; ++bj)
#pragma unroll
            for (int n = 0; n < 2; ++n) bv[bj][n] = *(const LAS f32x4*)(biasP + tile * 256 + bj * HALF + qc + 4 * n);
        if (tile < 8) epi_pair<0>(acc, bv, (bf16_t*)(ws + WS_H) + (tile & 7) * 128 + qc, row0);
        else if (tile < 16) epi_pair<1>(acc, bv, (bf16_t*)(ws + WS_UB) + (tile & 7) * 128 + qc, row0);
        else if (tile < 20) epi_solo<0>(acc, bv, (bf16_t*)(ws + WS_SA) + (tile & 3) * 256 + qc, row0, nullptr, fq);
        else if (tile < 24) epi_solo<1>(acc, bv, (bf16_t*)(ws + WS_V) + (tile & 3) * 256 + qc, row0, (float*)(ws + WS_VSTAT), fq);
        else epi_solo<2>(acc, bv, (bf16_t*)(ws + (tile < 28 ? WS_GA : WS_GB)) + (tile & 3) * 256 + qc, row0, nullptr, fq);
        return false;
    }
};

struct EpiP3 {
    static constexpr bool PERM = true, TWICE = false;
    const bf16_t *GA, *GB; bf16_t* MIX;
    __device__ __forceinline__ bool operator()(f32x4 (&acc)[2][2][4][2], const Unit& u, int wr, int wc, int fr, int fq) const {
        const int row0 = u.pm * BM + wr * 64 + fr, col0 = u.pn * BM + wc * 32 + 8 * fq;
        if (u.kind == 0) {
#pragma unroll
            for (int ai = 0; ai < 2; ++ai)
#pragma unroll
                for (int m = 0; m < 4; ++m) {
                    const size_t ro = (size_t)(row0 + ai * HALF + m * 16) * DM + col0;
#pragma unroll
                    for (int bj = 0; bj < 2; ++bj) {
                        const u32x4 gb = *(const u32x4*)(GB + ro + bj * HALF), ga = *(const u32x4*)(GA + ro + bj * HALF);
                        const float b[8] = {bf_lo(gb.x), bf_hi(gb.x), bf_lo(gb.y), bf_hi(gb.y), bf_lo(gb.z), bf_hi(gb.z), bf_lo(gb.w), bf_hi(gb.w)};
                        const float a[8] = {bf_lo(ga.x), bf_hi(ga.x), bf_lo(ga.y), bf_hi(ga.y), bf_lo(ga.z), bf_hi(ga.z), bf_lo(ga.w), bf_hi(ga.w)};
#pragma unroll
                        for (int n = 0; n < 2; ++n)
#pragma unroll
                            for (int j = 0; j < 4; ++j) acc[ai][bj][m][n][j] *= a[4 * n + j] * __builtin_amdgcn_rcpf(b[4 * n + j]);
                    }
                }
            return true;
        }
#pragma unroll
        for (int ai = 0; ai < 2; ++ai)
#pragma unroll
            for (int m = 0; m < 4; ++m) {
                const size_t ro = (size_t)(row0 + ai * HALF + m * 16) * DM + col0;
#pragma unroll
                for (int bj = 0; bj < 2; ++bj) {
                    const u32x4 gb = *(const u32x4*)(GB + ro + bj * HALF);
                    const float b[8] = {bf_lo(gb.x), bf_hi(gb.x), bf_lo(gb.y), bf_hi(gb.y), bf_lo(gb.z), bf_hi(gb.z), bf_lo(gb.w), bf_hi(gb.w)};
                    float o[8];
#pragma unroll
                    for (int n = 0; n < 2; ++n)
#pragma unroll
                        for (int j = 0; j < 4; ++j) o[4 * n + j] = acc[ai][bj][m][n][j] * b[4 * n + j];
                    u32x4 w; w.x = pk2(o[0], o[1]); w.y = pk2(o[2], o[3]); w.z = pk2(o[4], o[5]); w.w = pk2(o[6], o[7]);
                    *(u32x4*)(MIX + ro + bj * HALF) = w;
                }
            }
        return false;
    }
};

struct EpiP4 {
    static constexpr bool PERM = false, TWICE = false;
    const float *x, *bo; float* out; float* stat;
    __device__ __forceinline__ bool operator()(f32x4 (&acc)[2][2][4][2], const Unit& u, int wr, int wc, int fr, int fq) const {
        const int row0 = u.pm * BM + wr * 64 + fr, col0 = u.pn * BM + wc * 32 + 4 * fq;
        f32x4 bv[2][2];
#pragma unroll
        for (int bj = 0; bj < 2; ++bj)
#pragma unroll
            for (int n = 0; n < 2; ++n) bv[bj][n] = *(const f32x4*)(bo + col0 + bj * HALF + n * 16);
#pragma unroll
        for (int ai = 0; ai < 2; ++ai)
#pragma unroll
            for (int m = 0; m < 4; ++m) {
                const int row = row0 + ai * HALF + m * 16;
                const size_t ro = (size_t)row * DM + col0;
                float s1 = 0.f, s2 = 0.f;
#pragma unroll
                for (int bj = 0; bj < 2; ++bj)
#pragma unroll
                    for (int n = 0; n < 2; ++n) {
                        const f32x4 xv = *(const f32x4*)(x + ro + bj * HALF + n * 16);
                        const f32x4 y = acc[ai][bj][m][n] + bv[bj][n] + ALPHA * xv;
                        *(f32x4*)(out + ro + bj * HALF + n * 16) = y;
                        s1 += (y[0] + y[1]) + (y[2] + y[3]); s2 += (y[0] * y[0] + y[1] * y[1]) + (y[2] * y[2] + y[3] * y[3]);
                    }
                s1 += __shfl_xor(s1, 16); s1 += __shfl_xor(s1, 32); s2 += __shfl_xor(s2, 16); s2 += __shfl_xor(s2, 32);
                if (fq == 0) { __hip_atomic_fetch_add(stat + 2 * row, s1, __ATOMIC_RELAXED, __HIP_MEMORY_SCOPE_AGENT); __hip_atomic_fetch_add(stat + 2 * row + 1, s2, __ATOMIC_RELAXED, __HIP_MEMORY_SCOPE_AGENT); }
            }
        return false;
    }
};

#define XB_TMO      128
#define XB_XCNT(j)  (256  + 64 * (j))
#define XB_XSUB(j)  (1280 + 64 * (j))
#define XB_XGEN(j)  (2304 + 64 * (j))
#define XB_TOP      3328
#define XB_TOPGEN   3392
#define XCD_BAR_WORDS 3456
#define XB_SPIN_CAP (1u << 18)
__device__ __forceinline__ unsigned xb_ld(unsigned* p)              { return __hip_atomic_load(p, __ATOMIC_RELAXED, __HIP_MEMORY_SCOPE_AGENT); }
__device__ __forceinline__ unsigned xb_add(unsigned* p, unsigned v) { return __hip_atomic_fetch_add(p, v, __ATOMIC_RELAXED, __HIP_MEMORY_SCOPE_AGENT); }
__device__ __forceinline__ unsigned xb_xcc_id() { return (unsigned)__builtin_amdgcn_s_getreg((3 << 11) | 20) & 0xFu; }
#define XB_SPIN(cond, bar) do { unsigned _sp = 0; while (cond) { __builtin_amdgcn_s_sleep(1); \
    if ((++_sp & 255u) == 0u) { if (xb_ld(&(bar)[XB_TMO])) break; if (_sp > XB_SPIN_CAP) { atomicAdd(&(bar)[XB_TMO], 1u); break; } } } } while (0)
struct XcdBarrier { unsigned* bar; unsigned x; };
__device__ __forceinline__ XcdBarrier xcd_barrier_post(unsigned* bar) {
    XcdBarrier b; b.bar = bar; b.x = xb_xcc_id();
    if (threadIdx.x == 0) (void)xb_add(&bar[XB_XCNT(b.x)], 1u);
    return b;
}
__device__ __forceinline__ void xcd_barrier_complete(unsigned* bar, unsigned x, unsigned& nloc, unsigned& nx) {
    const unsigned G = gridDim.x * gridDim.y * gridDim.z;
    unsigned sum, cnt, mine, sp = 0u;
    for (;;) {
        sum = 0u; cnt = 0u; mine = 0u;
#pragma unroll
        for (unsigned j = 0; j < 16; ++j) { const unsigned c = xb_ld(&bar[XB_XCNT(j)]); sum += c; cnt += (c > 0u) ? 1u : 0u; mine = (j == x) ? c : mine; }
        if (sum == G) break;
        __builtin_amdgcn_s_sleep(1);
        if ((++sp & 255u) == 0u) { if (xb_ld(&bar[XB_TMO])) break; if (sp > XB_SPIN_CAP) { atomicAdd(&bar[XB_TMO], 1u); break; } }
    }
    nloc = mine > 0u ? mine : 1u; nx = cnt > 0u ? cnt : 1u;
}
__device__ __forceinline__ void xcd_barrier(const XcdBarrier& b) {
    asm volatile("s_waitcnt vmcnt(0)" ::: "memory");
    __syncthreads();
    if (threadIdx.x == 0) {
        unsigned* bar = b.bar;
        __builtin_amdgcn_s_waitcnt(0);
        unsigned* mine = bar + XCD_BAR_WORDS + 2 * blockIdx.x;
        unsigned nloc = mine[0], nx = mine[1];
        if (nloc == 0u) { xcd_barrier_complete(bar, b.x, nloc, nx); mine[0] = nloc; mine[1] = nx; }
        const unsigned old = xb_add(&bar[XB_XSUB(b.x)], 1u);
        const unsigned gen = old / nloc;
        if (old + 1u == (gen + 1u) * nloc) {
            __builtin_amdgcn_fence(__ATOMIC_RELEASE, "agent");
            asm volatile("s_waitcnt vmcnt(0)" ::: "memory");
            const unsigned og = xb_add(&bar[XB_TOP], 1u);
            const unsigned tg = og / nx;
            if (og + 1u == (tg + 1u) * nx) xb_add(&bar[XB_TOPGEN], 1u);
            else XB_SPIN(xb_ld(&bar[XB_TOPGEN]) == tg, bar);
            __builtin_amdgcn_fence(__ATOMIC_ACQUIRE, "agent");
            xb_add(&bar[XB_XGEN(b.x)], 1u);
            asm volatile("s_waitcnt vmcnt(0)" ::: "memory");
        } else {
            XB_SPIN(xb_ld(&bar[XB_XGEN(b.x)]) == gen, bar);
            __builtin_amdgcn_fence(__ATOMIC_ACQUIRE, "agent");
            asm volatile("s_waitcnt vmcnt(0)" ::: "memory");
        }
    }
    __syncthreads();
}

template <bool PERMUTE>
__device__ __forceinline__ void p0_transpose_item(const float* W, int K, int N, bf16_t* WT, LAS float* scr, int item, int lane) {
    const int nblk = N / 32, kb = item / nblk, nb = item % nblk, k0 = 64 * kb, n0 = 32 * nb;
    const int src0 = PERMUTE ? orig_col(n0) : n0;
    float wv[32];
#pragma unroll
    for (int i = 0; i < 32; ++i) wv[i] = W[(size_t)(k0 + 2 * i + (lane >> 5)) * N + src0 + (lane & 31)];
#pragma unroll
    for (int i = 0; i < 32; ++i) scr[(2 * i + (lane >> 5)) * 33 + (lane & 31)] = wv[i];
    asm volatile("s_waitcnt lgkmcnt(0)" ::: "memory");
    const int c = lane & 7;
#pragma unroll
    for (int j = 0; j < 4; ++j) { const int n = (lane >> 3) + 8 * j; const LAS float* s = scr + (8 * c) * 33 + n;
        u32x4 o; o.x = pk2(s[0 * 33], s[1 * 33]); o.y = pk2(s[2 * 33], s[3 * 33]); o.z = pk2(s[4 * 33], s[5 * 33]); o.w = pk2(s[6 * 33], s[7 * 33]);
        *(u32x4*)(WT + (size_t)(n0 + n) * K + k0 + 8 * c) = o; }
    asm volatile("s_waitcnt lgkmcnt(0)" ::: "memory");
}

__device__ __forceinline__ void p0_prologue(const Args& a, LAS unsigned char* lds, int tid, int wave, int lane) {
    unsigned char* ws = a.ws;
    const size_t gt = (size_t)blockIdx.x * 512 + tid, GT = (size_t)gridDim.x * 512;
    LAS float* scr = (LAS float*)(lds + wave * 16384);
    const int gw = blockIdx.x * 8 + wave, NGW = gridDim.x * 8;
    constexpr int I_IN = (DM / 64) * (DIN / 32), I_SQ = (DM / 64) * (DM / 32);
    for (int it = gw; it < I_IN + 3 * I_SQ; it += NGW) {
        int r = it;
        if (r < I_IN) { p0_transpose_item<true>(a.in[1], DM, DIN, (bf16_t*)(ws + WS_WIN), scr, r, lane); continue; } r -= I_IN;
        if (r < I_SQ) { p0_transpose_item<false>(a.in[11], DM, DM, (bf16_t*)(ws + WS_WPA), scr, r, lane); continue; } r -= I_SQ;
        if (r < I_SQ) { p0_transpose_item<false>(a.in[12], DM, DM, (bf16_t*)(ws + WS_WPB), scr, r, lane); continue; } r -= I_SQ;
        p0_transpose_item<false>(a.in[13], DM, DM, (bf16_t*)(ws + WS_WO), scr, r, lane);
    }
    if (gt < 8 * 128 * 128) { const int t = (int)(gt >> 7) & 127, s = (int)gt & 127; const float w = a.in[9][gt]; ((bf16_t*)(ws + WS_WS))[gt] = (s <= t) ? (bf16_t)(pk2(w, 0.f) & 0xffffu) : (bf16_t)0; }
    if (gt < DIN) ((float*)(ws + WS_BIAS))[gt] = a.in[2][orig_col((int)gt)];
    if (gt < 2 * NTOK) { ((float*)(ws + WS_STAT))[gt] = 0.f; ((float*)(ws + WS_VSTAT))[gt] = 0.f; }
    const f32x4* x4 = (const f32x4*)a.in[0]; u32x4* xb = (u32x4*)(ws + WS_XB);
    constexpr size_t NX = (size_t)NTOK * DM / 8;
    size_t i = gt;
    for (; i + 3 * GT < NX; i += 4 * GT) {
        f32x4 p[4], q[4];
#pragma unroll
        for (int k = 0; k < 4; ++k) { p[k] = __builtin_nontemporal_load(x4 + 2 * (i + k * GT)); q[k] = __builtin_nontemporal_load(x4 + 2 * (i + k * GT) + 1); }
#pragma unroll
        for (int k = 0; k < 4; ++k) { u32x4 o; o.x = pk2(p[k][0], p[k][1]); o.y = pk2(p[k][2], p[k][3]); o.z = pk2(q[k][0], q[k][1]); o.w = pk2(q[k][2], q[k][3]); xb[i + k * GT] = o; }
    }
    for (; i < NX; i += GT) {
        const f32x4 p = x4[2 * i], q = x4[2 * i + 1];
        u32x4 o; o.x = pk2(p[0], p[1]); o.y = pk2(p[2], p[3]); o.z = pk2(q[0], q[1]); o.w = pk2(q[2], q[3]);
        xb[i] = o;
    }
}


template <int O, int N> __device__ __forceinline__ void tr_step(float (&v)[32], int lane) {
    const bool up = (lane & O) != 0;
#pragma unroll
    for (int i = 0; i < N; ++i) { const float send = up ? v[i] : v[i + N]; const float keep = up ? v[i + N] : v[i]; v[i] = keep + __shfl_xor(send, O); }
}
template <int O, int N> __device__ __forceinline__ void tr_step16(float (&v)[16], int lane) {
    const bool up = (lane & O) != 0;
#pragma unroll
    for (int i = 0; i < N; ++i) { const float send = up ? v[i] : v[i + N]; const float keep = up ? v[i + N] : v[i]; v[i] = keep + __shfl_xor(send, O); }
}
__device__ __forceinline__ float tr_reduce16(float (&v)[16], int lane) {
    tr_step16<32, 8>(v, lane); tr_step16<16, 4>(v, lane); tr_step16<8, 2>(v, lane); tr_step16<4, 1>(v, lane);
    float r = v[0]; r += __shfl_xor(r, 2); r += __shfl_xor(r, 1); return r;
}
__device__ __forceinline__ float tr_reduce32(float (&v)[32], int lane) {
    tr_step<32, 16>(v, lane); tr_step<16, 8>(v, lane); tr_step<8, 4>(v, lane); tr_step<4, 2>(v, lane); tr_step<2, 1>(v, lane);
    return v[0] + __shfl_xor(v[0], 1);
}

__device__ __forceinline__ void p2_conv(const Args& a, int chunk, int cw  , int lane, bool dummy = false) {
    const bf16_t* H = (const bf16_t*)(a.ws + WS_H); bf16_t* SA = (bf16_t*)(a.ws + WS_SA);
    const float *conv_w = a.in[3], *conv_b = a.in[4], *gn_g = a.in[5], *gn_b = a.in[6];
    const bool has_prev = (chunk & 15) != 0;
    const long R0 = (long)chunk * 128;
#pragma unroll 1
    for (int gi = 0; gi < 2; ++gi) {
        const int cg0 = (2 * cw + gi) * 128, c = cg0 + 2 * lane;
        const char* Hg = (const char*)(H + R0 * DM + cg0); char* Sg = (char*)(SA + R0 * DM + cg0); char* Og = dummy ? (char*)((bf16_t*)(a.ws + WS_XB) + R0 * DM + cg0) : Sg;
        const unsigned lo = (unsigned)lane * 4u;
#define HROW(r) (*(const unsigned*)(Hg + (long)(r) * (DM * 2) + lo))
#define SROW(r) (*(unsigned*)(Sg + (long)(r) * (DM * 2) + lo))
        f32x2 w[31];
#pragma unroll
        for (int j = 0; j < 31; ++j) w[j] = *(const f32x2*)(conv_w + j * DM + c);
        unsigned win[38];
#pragma unroll
        for (int k = 0; k < 30; ++k) { win[k] = 0u; if (has_prev) win[k] = HROW(k - 30); }
#pragma unroll
        for (int k = 0; k < 8; ++k) win[30 + k] = HROW(k);
#pragma unroll 1
        for (int sl = 0; sl < 16; ++sl) {
            const int t0 = sl * 8;
            unsigned nxt[8], sraw[8];
            const int tn = sl < 15 ? t0 + 8 : t0;
#pragma unroll
            for (int k = 0; k < 8; ++k) nxt[k] = HROW(tn + k);
#pragma unroll
            for (int k = 0; k < 8; ++k) sraw[k] = SROW(t0 + k);
            const f32x2 cb = *(const f32x2*)(conv_b + c);
            f32x2 acc[8];
#pragma unroll
            for (int t = 0; t < 8; ++t) acc[t] = (f32x2){0.f, 0.f};
#pragma unroll
            for (int idx = 0; idx < 38; ++idx) { const f32x2 hv = {bf_lo(win[idx]), bf_hi(win[idx])};
#pragma unroll
                for (int t = 0; t < 8; ++t) { const int j = idx - t; if (j >= 0 && j <= 30) acc[t] += w[j] * hv; } }
            const f32x2 gg = *(const f32x2*)(gn_g + c), gb = *(const f32x2*)(gn_b + c);
            float q[16];
#pragma unroll
            for (int t = 0; t < 8; ++t) { acc[t] += cb; q[2 * t] = acc[t].x + acc[t].y; q[2 * t + 1] = acc[t].x * acc[t].x + acc[t].y * acc[t].y; }
            const float tot = tr_reduce16(q, lane);
            const float oth = __shfl_xor(tot, 4);
            const bool issq = (lane & 4) != 0;
            const float s1 = issq ? oth : tot, s2 = issq ? tot : oth;
            const float mean = s1 * (1.f / 128.f), var = fmaxf(s2 * (1.f / 128.f) - mean * mean, 0.f), rstd = __builtin_amdgcn_rsqf(var + LN_EPS);
#pragma unroll
            for (int t = 0; t < 8; ++t) {
                const float mt = __int_as_float(__builtin_amdgcn_readlane(__float_as_int(mean), 8 * t)), rt = __int_as_float(__builtin_amdgcn_readlane(__float_as_int(rstd), 8 * t));
                const float y0 = (acc[t].x - mt) * rt * gg.x + gb.x, y1 = (acc[t].y - mt) * rt * gg.y + gb.y;
                *(unsigned*)(Og + (long)(t0 + t) * (DM * 2) + lo) = pk2(fsilu(y0) * bf_lo(sraw[t]), fsilu(y1) * bf_hi(sraw[t]));
            }
#pragma unroll
            for (int k = 0; k < 30; ++k) win[k] = win[k + 8];
#pragma unroll
            for (int k = 0; k < 8; ++k) win[30 + k] = nxt[k];
        }
#undef HROW
#undef SROW
    }
}

__device__ __forceinline__ void p2_gmlp(const Args& a, LAS unsigned char* lds, int chunk, int gw  , int lane, bool dummy = false) {
    const bf16_t* V = (const bf16_t*)(a.ws + WS_V); bf16_t* UB = (bf16_t*)(a.ws + WS_UB); const bf16_t* WsB = (const bf16_t*)(a.ws + WS_WS);
    const float* vstat = (const float*)(a.ws + WS_VSTAT);
    const float *ln_g = a.in[7], *ln_b = a.in[8], *b_sp = a.in[10];
    LAS unsigned char* vt = lds + gw * 32768;
    LAS f32x2* st = (LAS f32x2*)(lds + 4 * 32768 + gw * 1024);
    const long R0 = (long)chunk * 128;
    const int fr = lane & 15, fq = lane >> 4;
#pragma unroll
    for (int k = 0; k < 2; ++k) { const int t = lane + 64 * k; const f32x2 sv = *(const f32x2*)(vstat + 2 * (R0 + t));
        const float mean = sv.x * (1.f / 1024.f), var = fmaxf(sv.y * (1.f / 1024.f) - mean * mean, 0.f), rstd = __builtin_amdgcn_rsqf(var + LN_EPS);
        st[t] = (f32x2){rstd, -mean * rstd}; }
#pragma unroll 1
    for (int hh = 0; hh < 2; ++hh) {
        const int h = 2 * gw + hh;
        const int d8 = lane & 15, sq = lane >> 4;
        const f32x4 g0 = *(const f32x4*)(ln_g + h * 128 + d8 * 8), g1 = *(const f32x4*)(ln_g + h * 128 + d8 * 8 + 4);
        const f32x4 e0 = *(const f32x4*)(ln_b + h * 128 + d8 * 8), e1 = *(const f32x4*)(ln_b + h * 128 + d8 * 8 + 4);
        const float gk[8] = {g0[0], g0[1], g0[2], g0[3], g1[0], g1[1], g1[2], g1[3]}, ek[8] = {e0[0], e0[1], e0[2], e0[3], e1[0], e1[1], e1[2], e1[3]};
#pragma unroll 1
        for (int it = 0; it < 4; ++it) {
            const int sg = it * 4 + sq;
            u32x4 raw[8];
#pragma unroll
            for (int e = 0; e < 8; ++e) raw[e] = *(const u32x4*)(V + (R0 + sg * 8 + e) * DM + h * 128 + d8 * 8);
            float val[8][8];
#pragma unroll
            for (int e = 0; e < 8; ++e) { const f32x2 sc = st[sg * 8 + e];
#pragma unroll
                for (int k = 0; k < 4; ++k) { val[e][2 * k] = (bf_lo(raw[e][k]) * sc.x + sc.y) * gk[2 * k] + ek[2 * k]; val[e][2 * k + 1] = (bf_hi(raw[e][k]) * sc.x + sc.y) * gk[2 * k + 1] + ek[2 * k + 1]; } }
#pragma unroll
            for (int k = 0; k < 8; ++k) { const int d = d8 * 8 + k;
                u32x4 o; o.x = pk2(val[0][k], val[1][k]); o.y = pk2(val[2][k], val[3][k]); o.z = pk2(val[4][k], val[5][k]); o.w = pk2(val[6][k], val[7][k]);
                *(LAS u32x4*)(vt + d * 256 + ((sg + d + (d >> 3)) & 15) * 16) = o; }
        }
#pragma unroll 1
        for (int tb = 0; tb < 4; ++tb) {
            f32x4 acc[2][8];
#pragma unroll
            for (int mi = 0; mi < 2; ++mi)
#pragma unroll
                for (int ni = 0; ni < 8; ++ni) acc[mi][ni] = (f32x4){0.f, 0.f, 0.f, 0.f};
            bf16x8 wf[4][2];
#pragma unroll
            for (int ks = 0; ks < 4; ++ks)
#pragma unroll
                for (int mi = 0; mi < 2; ++mi) { const int kk = ks <= tb ? ks : tb;
                    wf[ks][mi] = *(const bf16x8*)(WsB + (size_t)((h * 128 + 32 * tb + 16 * mi + fr) * 128 + kk * 32 + fq * 8)); }
#pragma unroll
            for (int ks = 0; ks < 4; ++ks) {
                if (ks <= tb) {
                    bf16x8 vf[8];
#pragma unroll
                    for (int ni = 0; ni < 8; ++ni) { const int dd = 16 * ni + fr; vf[ni] = *(const LAS bf16x8*)(vt + dd * 256 + (((ks * 4 + fq) + dd + (dd >> 3)) & 15) * 16); }
#pragma unroll
                    for (int mi = 0; mi < 2; ++mi)
#pragma unroll
                        for (int ni = 0; ni < 8; ++ni) acc[mi][ni] = __builtin_amdgcn_mfma_f32_16x16x32_bf16(vf[ni], wf[ks][mi], acc[mi][ni], 0, 0, 0);
                }
            }
#pragma unroll
            for (int mi = 0; mi < 2; ++mi) {
                const int t = 32 * tb + 16 * mi + fr;
                const float bsp = b_sp[h * 128 + t];
                u32x2* prow = (u32x2*)(UB + (R0 + t) * DM + h * 128 + 4 * fq);
                u32x2 ub[8];
#pragma unroll
                for (int ni = 0; ni < 8; ++ni) ub[ni] = prow[4 * ni];
#pragma unroll
                for (int ni = 0; ni < 8; ++ni) {
                    u32x2 o; o.x = pk2((acc[mi][ni][0] + bsp) * bf_lo(ub[ni].x), (acc[mi][ni][1] + bsp) * bf_hi(ub[ni].x));
                    o.y = pk2((acc[mi][ni][2] + bsp) * bf_lo(ub[ni].y), (acc[mi][ni][3] + bsp) * bf_hi(ub[ni].y));
                    (dummy ? (u32x2*)((bf16_t*)(a.ws + WS_XB) + (R0 + t) * DM + h * 128 + 4 * fq) : prow)[4 * ni] = o;
                }
            }
        }
    }
}

__device__ __forceinline__ void p5_ln(const Args& a, int wave, int lane) {
    const float* stat = (const float*)(a.ws + WS_STAT);
    const f32x4* g4 = (const f32x4*)a.in[15]; const f32x4* b4 = (const f32x4*)a.in[16];
    f32x4 gg[4], bb[4];
#pragma unroll
    for (int j = 0; j < 4; ++j) { gg[j] = g4[lane + 64 * j]; bb[j] = b4[lane + 64 * j]; }
    for (int row = blockIdx.x * 8 + wave; row < NTOK; row += gridDim.x * 8) {
        const float s1 = stat[2 * row], s2 = stat[2 * row + 1];
        const float mean = s1 * (1.f / 1024.f), var = fmaxf(s2 * (1.f / 1024.f) - mean * mean, 0.f), rstd = __builtin_amdgcn_rsqf(var + LN_EPS);
        f32x4* p = (f32x4*)(a.out + (size_t)row * DM) + lane;
        f32x4 v[4];
#pragma unroll
        for (int j = 0; j < 4; ++j) v[j] = p[64 * j];
#pragma unroll
        for (int j = 0; j < 4; ++j) p[64 * j] = (v[j] - mean) * rstd * gg[j] + bb[j];
    }
}

__global__ void __launch_bounds__(512) fwd_megakernel(Args a) {
    extern __shared__ __attribute__((aligned(16))) unsigned char lds_raw[];
    LAS unsigned char* lds = (LAS unsigned char*)lds_raw;
    const int tid = threadIdx.x, lane = tid & 63, wave = __builtin_amdgcn_readfirstlane(tid >> 6);
    const int G = gridDim.x, c = blockIdx.x;
    unsigned char* ws = a.ws;
    const int lo = a.ph_lo, hi = a.ph_hi;
#define IN(k) (lo <= (k) && (k) < hi)
#ifdef PROBE_PHASE
    unsigned long long tstamp[7]; int nst = 0;
#define STAMP() do { tstamp[nst++] = __builtin_amdgcn_s_memrealtime(); } while (0)
#else
#define STAMP() do {} while (0)
#endif
    const XcdBarrier gbar = xcd_barrier_post((unsigned*)(a.ws + WS_CTL));
#define SEAM(k) do { if (IN(k) && IN((k) + 1)) xcd_barrier(gbar); STAMP(); } while (0)
    STAMP();

    if (IN(0)) { p0_prologue(a, lds, tid, wave, lane); }
    SEAM(0);
    if (IN(1)) {
        SchedSimple S{(const char*)(ws + WS_XB), (const char*)(ws + WS_WIN), NTOK / BM, DIN / BM, G, c};
        LAS float* lbias = (LAS float*)(lds + BIAS_OFF);
        for (int i = tid; i < DIN; i += 512) lbias[i] = a.in[2][orig_col(i)];
        __syncthreads();
        EpiP1 E{lbias, ws};
        gemm_phase(lds, S, E);
    }
    SEAM(1);
    if (IN(2)) {
        for (int chunk = c; chunk < NTOK / 128; chunk += G) {
#if defined(PROBE_GMLP2X)
            if (wave < 4) { p2_gmlp(a, lds, chunk, wave, lane, true); p2_gmlp(a, lds, chunk, wave, lane); } else p2_conv(a, chunk, wave - 4, lane);
#elif defined(PROBE_CONV2X)
            if (wave < 4) p2_gmlp(a, lds, chunk, wave, lane); else { p2_conv(a, chunk, wave - 4, lane, true); p2_conv(a, chunk, wave - 4, lane); }
#else
            if (wave < 4) p2_gmlp(a, lds, chunk, wave, lane); else p2_conv(a, chunk, wave - 4, lane);
#endif
        }
    }
    SEAM(2);
    if (IN(3)) {
        SchedDual S{(const char*)(ws + WS_SA), (const char*)(ws + WS_WPA), (const char*)(ws + WS_UB), (const char*)(ws + WS_WPB), NTOK / BM, DM / BM, G, c};
        EpiP3 E{(const bf16_t*)(ws + WS_GA), (const bf16_t*)(ws + WS_GB), (bf16_t*)(ws + WS_MIX)};
        gemm_phase(lds, S, E);
    }
    SEAM(3);
    if (IN(4)) {
        SchedSimple S{(const char*)(ws + WS_MIX), (const char*)(ws + WS_WO), NTOK / BM, DM / BM, G, c};
        EpiP4 E{a.in[0], a.in[14], a.out, (float*)(ws + WS_STAT)};
        gemm_phase(lds, S, E);
    }
    SEAM(4);
    if (IN(5)) { p5_ln(a, wave, lane); }
#ifdef PROBE_PHASE
    STAMP();
    if (c == 0 && tid == 0) {
        int bi = 0; float bm = 1e30f;
        for (int i = 0; i < 64; ++i) { const float v = fabsf(a.out[i]); if (v < bm) { bm = v; bi = i; } }
        a.out[bi] += (float)(tstamp[PROBE_PHASE + 1] - tstamp[PROBE_PHASE]) * 0.01f * (1.f / 4000.f);
    }
#endif
}

extern "C" void kernel_launch(void* const* d_in, const int* in_sizes, int n_in, void* d_out, int out_size, void* d_ws, size_t ws_size, hipStream_t stream) {
    static int grid = 0;
    if (grid == 0) {
        if (n_in != 17 || in_sizes[0] != NTOK * DM || out_size != NTOK * DM || ws_size < WS_END) {
            fprintf(stderr, "kernel_launch: unexpected shapes (n_in %d, in0 %d, out %d, ws %zu < %zu); nothing launched\n", n_in, n_in > 0 ? in_sizes[0] : -1, out_size, ws_size, (size_t)WS_END); grid = -1; return; }
        int dev = 0, cus = 0, per_cu = 0;
        (void)hipGetDevice(&dev);
        (void)hipDeviceGetAttribute(&cus, hipDeviceAttributeMultiprocessorCount, dev);
        if (hipFuncSetAttribute((const void*)fwd_megakernel, hipFuncAttributeMaxDynamicSharedMemorySize, LDS_BYTES) != hipSuccess) { fprintf(stderr, "kernel_launch: hipFuncSetAttribute failed\n"); grid = -1; return; }
        if (hipOccupancyMaxActiveBlocksPerMultiprocessor(&per_cu, (const void*)fwd_megakernel, 512, LDS_BYTES) != hipSuccess || per_cu < 1) { fprintf(stderr, "kernel_launch: occupancy query failed (%d)\n", per_cu); (void)hipGetLastError(); per_cu = 1; }
        if (per_cu > 1) per_cu = 1;
        grid = cus * per_cu;
    }
    if (grid < 0) return;
    if (hipMemsetAsync((char*)d_ws + WS_CTL, 0, CTL_BYTES, stream) != hipSuccess) { fprintf(stderr, "kernel_launch: hipMemsetAsync of the barrier words failed\n"); return; }
    Args a{};
    for (int i = 0; i < 17; ++i) a.in[i] = (const float*)d_in[i];
    a.out = (float*)d_out; a.ws = (unsigned char*)d_ws;
#if N_LAUNCHES == 1
    a.ph_lo = 0; a.ph_hi = 6;
    void* args[] = {&a};
    hipError_t e = hipLaunchCooperativeKernel((const void*)fwd_megakernel, dim3(grid), dim3(512), args, LDS_BYTES, stream);
    if (e != hipSuccess) fprintf(stderr, "cooperative launch failed: %s (grid %d)\n", hipGetErrorString(e), grid);
#else
    for (int ph = 0; ph < 6; ++ph) {
        a.ph_lo = ph; a.ph_hi = ph + 1;
        hipLaunchKernelGGL(fwd_megakernel, dim3(grid), dim3(512), LDS_BYTES, stream, a);
    }
#endif
}
```

```cpp
#include <hip/hip_runtime.h>
#include <hip/hip_cooperative_groups.h>
#include <cstdio>
#include <cstdint>
namespace cg = cooperative_groups;

#ifndef N_LAUNCHES
#define N_LAUNCHES 1
#endif

#define LAS __attribute__((address_space(3)))
typedef unsigned short bf16_t;
typedef short bf16x8 __attribute__((ext_vector_type(8)));
typedef float f32x4 __attribute__((ext_vector_type(4)));
typedef float f32x2 __attribute__((ext_vector_type(2)));
typedef unsigned u32x4 __attribute__((ext_vector_type(4)));
typedef unsigned u32x2 __attribute__((ext_vector_type(2)));

constexpr int DM = 1024, NTOK = 32768, DIN = 8192;
constexpr float LN_EPS = 1e-5f;
constexpr float ALPHA = 1.189207115002721f;
constexpr int BM = 256, BK = 64, HALF = 128, HTB = HALF * BK * 2, STAGE_BYTES = 8 * HTB, WGM = 8;
constexpr int BIAS_OFF = STAGE_BYTES;
constexpr int LDS_BYTES = STAGE_BYTES + DIN * 4;
constexpr int KDIM = 1024;

constexpr size_t MiB = (size_t)1 << 20;
constexpr size_t WS_XB = 0, WS_H = 64 * MiB, WS_SA = 128 * MiB, WS_UB = 192 * MiB, WS_V = 256 * MiB, WS_GA = 320 * MiB, WS_GB = 384 * MiB;
constexpr size_t WS_WIN = 448 * MiB, WS_WPA = 464 * MiB, WS_WPB = 466 * MiB, WS_WO = 468 * MiB, WS_WS = 470 * MiB;
constexpr size_t WS_BIAS = WS_WS + 256 * 1024, WS_STAT = WS_BIAS + 256 * 1024, WS_VSTAT = WS_STAT + 256 * 1024, WS_CTL = 471 * MiB, WS_END = 472 * MiB;
constexpr size_t WS_MIX = WS_XB;
constexpr size_t CTL_BYTES = 32768;

struct Args {
    const float* in[17];
    float* out;
    unsigned char* ws;
    int ph_lo, ph_hi;
};

typedef __bf16 bf16x2_t __attribute__((ext_vector_type(2)));
__device__ __forceinline__ unsigned pk2(float lo, float hi) { const f32x2 v = {lo, hi}; return __builtin_bit_cast(unsigned, __builtin_convertvector(v, bf16x2_t)); }
__device__ __forceinline__ float bf_lo(unsigned u) { return __uint_as_float(u << 16); }
__device__ __forceinline__ float bf_hi(unsigned u) { return __uint_as_float(u & 0xffff0000u); }
#ifdef PROBE_NOACT
__device__ __forceinline__ float fsigmoid(float x) { return 0.5f + 0.01f * x; }
__device__ __forceinline__ float fsigmoid_unused(float x) {
#else
__device__ __forceinline__ float fsigmoid(float x) {
#endif
    return __builtin_amdgcn_rcpf(1.0f + __builtin_amdgcn_exp2f(-1.4426950408889634f * x)); }
__device__ __forceinline__ float fsilu(float x) { return x * fsigmoid(x); }
__device__ __forceinline__ float fgelu(float x) { return x * fsigmoid(1.5957691216057308f * (x + 0.044715f * x * x * x)); }
__device__ __forceinline__ float wave_sum(float v) {
#pragma unroll
    for (int o = 1; o < 64; o <<= 1) v += __shfl_xor(v, o);
    return v;
}
__host__ __device__ __forceinline__ int orig_col(int p) {
    const int tile = p >> 8, q = p & 255;
    if (tile < 8) return (q < 128) ? tile * 128 + q : 1024 + tile * 128 + (q - 128);
    if (tile < 16) { const int tt = tile - 8; return (q < 128) ? 3072 + tt * 128 + q : 5120 + tt * 128 + (q - 128); }
    if (tile < 20) return 2048 + (tile - 16) * 256 + q;
    if (tile < 24) return 4096 + (tile - 20) * 256 + q;
    if (tile < 28) return 6144 + (tile - 24) * 256 + q;
    return 7168 + (tile - 28) * 256 + q;
}

__host__ __device__ __forceinline__ int lds_byte(int r, int c) { const int st = (r >> 4) * 2 + (c >> 5), rr = r & 15, cc = c & 31, ob = rr * 64 + cc * 2; return st * 1024 + (ob ^ (((ob >> 9) & 1) << 5)); }
__host__ __device__ __forceinline__ void stage_rc(int b, int& R, int& C) { const int st = b / 1024, sb = b % 1024, swz = sb ^ (((sb >> 9) & 1) << 5); R = (st >> 1) * 16 + swz / 64; C = (st & 1) * 32 + (swz % 64) / 2; }
__host__ __device__ __forceinline__ int perm32(int rho) { const int n = rho >> 4, i = rho & 15; return 8 * (i >> 2) + 4 * n + (i & 3); }

struct Unit { const char* A; const char* B; int pm, pn, kind; };

__device__ __forceinline__ bool tile_order(long L, int nM, int nN, int& pm, int& pn) {
    const int nwg = nM * nN; if (L >= nwg) return false;
    int wgid = (int)L; { const int q = nwg / 8, r = nwg % 8, xcd = wgid % 8, off = wgid / 8; wgid = (xcd < r ? xcd * (q + 1) : r * (q + 1) + (xcd - r) * q) + off; }
    const int nig = WGM * nN, gid = wgid / nig, fm = gid * WGM, gsz = (nM - fm) < WGM ? (nM - fm) : WGM;
    pm = fm + ((wgid % nig) % gsz); pn = (wgid % nig) / gsz; return true;
}
constexpr size_t TSTEP = (size_t)BM * KDIM * 2;

struct SchedSimple {
    const char* A; const char* B; int nM, nN, G, c;
    __device__ __forceinline__ bool next(int i, Unit& u) const {
        if (!tile_order((long)i * G + c, nM, nN, u.pm, u.pn)) return false;
        u.A = A + (size_t)u.pm * TSTEP; u.B = B + (size_t)u.pn * TSTEP; u.kind = 1; return true;
    }
};
struct SchedDual {
    const char *A0, *B0, *A1, *B1; int nM, nN, G, c;
    __device__ __forceinline__ bool next(int i, Unit& u) const {
        if (!tile_order((long)(i >> 1) * G + c, nM, nN, u.pm, u.pn)) return false;
        u.kind = i & 1;
        u.A = (u.kind ? A1 : A0) + (size_t)u.pm * TSTEP; u.B = (u.kind ? B1 : B0) + (size_t)u.pn * TSTEP; return true;
    }
};

template <class Epi, class Sched>
__device__ __forceinline__ void gemm_phase(LAS unsigned char* lds, const Sched& S, const Epi& E) {
    const int tid = threadIdx.x, wid = __builtin_amdgcn_readfirstlane(tid >> 6), lane = tid & 63, wr = wid >> 2, wc = wid & 3, fr = lane & 15, fq = lane >> 4;
    constexpr int K = KDIM, nt = K / BK;
    unsigned voffA[2], voffB[2];
#pragma unroll
    for (int i = 0; i < 2; ++i) { int R, C; stage_rc(tid * 16 + i * 8192, R, C); const int Rb = Epi::PERM ? ((R & ~31) + perm32(R & 31)) : R;
        voffA[i] = (unsigned)(R * K + C) * 2u; voffB[i] = (unsigned)(Rb * K + C) * 2u; }
    constexpr size_t kstep = (size_t)(BK * 2);
    constexpr size_t hstep = (size_t)HALF * K * 2;
    const unsigned ldsw = (unsigned)wid * 1024u;
    const int aoff = lds_byte(wr * 64 + fr, fq * 8), boff = lds_byte(wc * 32 + fr, fq * 8);
#define PG8_SA(b, h) (((b) * 2 + (h)) * HTB)
#define PG8_SB(b, h) ((4 + (b) * 2 + (h)) * HTB)
#define PG8_STAGE(bufoff, gbase, voff) do { _Pragma("unroll") for (int _i = 0; _i < 2; ++_i) \
        __builtin_amdgcn_global_load_lds((const unsigned*)((const char*)(gbase) + (voff)[_i]), (LAS unsigned*)(lds + (bufoff) + ldsw + _i * 8192), 16, 0, 0); } while (0)
#define PG8_LDA(dst, b, h) do { _Pragma("unroll") for (int m = 0; m < 4; ++m) _Pragma("unroll") for (int k = 0; k < 2; ++k) dst[m][k] = *(const LAS bf16x8*)(lds + PG8_SA(b, h) + aoff + m * 2048 + k * 1024); } while (0)
#define PG8_LDB(dst, b, h) do { _Pragma("unroll") for (int n = 0; n < 2; ++n) _Pragma("unroll") for (int k = 0; k < 2; ++k) dst[n][k] = *(const LAS bf16x8*)(lds + PG8_SB(b, h) + boff + n * 2048 + k * 1024); } while (0)
#define PG8_MMA(ai, bj, At, Bt) do { __builtin_amdgcn_s_setprio(1); _Pragma("unroll") for (int m = 0; m < 4; ++m) _Pragma("unroll") for (int n = 0; n < 2; ++n) _Pragma("unroll") for (int k = 0; k < 2; ++k) \
        acc[ai][bj][m][n] = __builtin_amdgcn_mfma_f32_16x16x32_bf16(Bt[n][k], At[m][k], acc[ai][bj][m][n], 0, 0, 0); __builtin_amdgcn_s_setprio(0); } while (0)
#define PG8_WAIT_V(n) asm volatile("s_waitcnt vmcnt(" #n ")" ::: "memory")
#define PG8_WAIT_L(n) asm volatile("s_waitcnt lgkmcnt(" #n ")" ::: "memory")
#define PG8_BAR __builtin_amdgcn_s_barrier()
#define PG8_SCHED __builtin_amdgcn_sched_barrier(0)
    Unit cur, nxt; int ui = 0;
    if (!S.next(0, cur)) return;
    f32x4 acc[2][2][4][2];
#pragma unroll
    for (int a = 0; a < 2; ++a)
#pragma unroll
        for (int b = 0; b < 2; ++b)
#pragma unroll
            for (int m = 0; m < 4; ++m)
#pragma unroll
                for (int n = 0; n < 2; ++n) acc[a][b][m][n] = (f32x4){0.f, 0.f, 0.f, 0.f};
    bf16x8 At[4][2], B0[2][2], B1[2][2];
    const char* cA = cur.A; const char* cB = cur.B;
    PG8_STAGE(PG8_SB(0, 0), cB, voffB); PG8_STAGE(PG8_SB(0, 1), cB + hstep, voffB); PG8_STAGE(PG8_SA(0, 0), cA, voffA); PG8_STAGE(PG8_SA(0, 1), cA + hstep, voffA);
    if (wr == 1) PG8_BAR;
    PG8_WAIT_V(2); PG8_BAR;
    PG8_STAGE(PG8_SB(1, 0), cB + kstep, voffB); PG8_STAGE(PG8_SA(1, 0), cA + kstep, voffA); PG8_STAGE(PG8_SB(1, 1), cB + hstep + kstep, voffB);
    PG8_WAIT_V(6); PG8_BAR;
    for (;;) {
        const bool has_next = S.next(ui + 1, nxt);
        const char* nA = has_next ? nxt.A : cA; const char* nB = has_next ? nxt.B : cB;
        for (int t = 0; t < nt; t += 2) {
            const bool last = (t == nt - 2);
            const char* a1 = cA + (size_t)(t + 1) * kstep;
            const char* a2 = last ? nA : cA + (size_t)(t + 2) * kstep; const char* b2 = last ? nB : cB + (size_t)(t + 2) * kstep;
            const char* a3 = a2 + kstep; const char* b3 = b2 + kstep;
            PG8_LDB(B0, 0, 0); PG8_LDB(B1, 0, 1); PG8_SCHED; PG8_LDA(At, 0, 0); PG8_STAGE(PG8_SA(1, 1), a1 + hstep, voffA);
            PG8_WAIT_V(8); PG8_WAIT_L(0); PG8_BAR; PG8_MMA(0, 0, At, B0); PG8_MMA(0, 1, At, B1); PG8_BAR; PG8_SCHED;
            PG8_LDA(At, 0, 1); PG8_STAGE(PG8_SB(0, 0), b2, voffB); PG8_STAGE(PG8_SB(0, 1), b2 + hstep, voffB); PG8_STAGE(PG8_SA(0, 0), a2, voffA);
            PG8_WAIT_V(8); PG8_WAIT_L(0); PG8_BAR; PG8_MMA(1, 0, At, B0); PG8_MMA(1, 1, At, B1); PG8_BAR; PG8_SCHED;
            PG8_LDB(B0, 1, 0); PG8_LDB(B1, 1, 1); PG8_SCHED; PG8_LDA(At, 1, 0); PG8_STAGE(PG8_SA(0, 1), a2 + hstep, voffA);
            PG8_WAIT_V(8); PG8_WAIT_L(0); PG8_BAR; PG8_MMA(0, 0, At, B0); PG8_MMA(0, 1, At, B1); PG8_BAR; PG8_SCHED;
            PG8_LDA(At, 1, 1); PG8_STAGE(PG8_SB(1, 0), b3, voffB); PG8_STAGE(PG8_SB(1, 1), b3 + hstep, voffB); PG8_STAGE(PG8_SA(1, 0), a3, voffA);
            PG8_WAIT_V(8); PG8_WAIT_L(0); PG8_BAR; PG8_MMA(1, 0, At, B0); PG8_MMA(1, 1, At, B1); PG8_BAR; PG8_SCHED;
        }
        if (wr == 0) PG8_BAR;
#ifdef PROBE_EPI2X
        if (Epi::TWICE) { E(acc, cur, wr, wc, fr, fq);
            _Pragma("unroll") for (int a = 0; a < 2; ++a) _Pragma("unroll") for (int b = 0; b < 2; ++b) _Pragma("unroll") for (int m = 0; m < 4; ++m) _Pragma("unroll") for (int n = 0; n < 2; ++n) asm volatile("" : "+v"(acc[a][b][m][n]) :: "memory"); }
#endif
        const bool keep = E(acc, cur, wr, wc, fr, fq);
        if (!has_next) break;
        if (!keep) {
#pragma unroll
            for (int a = 0; a < 2; ++a)
#pragma unroll
                for (int b = 0; b < 2; ++b)
#pragma unroll
                    for (int m = 0; m < 4; ++m)
#pragma unroll
                        for (int n = 0; n < 2; ++n) acc[a][b][m][n] = (f32x4){0.f, 0.f, 0.f, 0.f};
        }
        cur = nxt; cA = nA; cB = nB; ++ui;
        if (wr == 1) PG8_BAR;
    }
    PG8_WAIT_V(0);
    PG8_BAR;
#undef PG8_SA
#undef PG8_SB
#undef PG8_STAGE
#undef PG8_LDA
#undef PG8_LDB
#undef PG8_MMA
#undef PG8_WAIT_V
#undef PG8_WAIT_L
#undef PG8_BAR
#undef PG8_SCHED
}

constexpr float NLOG2E = -1.4426950408889634f;
__device__ __forceinline__ f32x2 exp2_2(f32x2 t) { return (f32x2){__builtin_amdgcn_exp2f(t.x), __builtin_amdgcn_exp2f(t.y)}; }
__device__ __forceinline__ f32x2 rcp_2(f32x2 t) { return (f32x2){__builtin_amdgcn_rcpf(t.x), __builtin_amdgcn_rcpf(t.y)}; }
__device__ __forceinline__ f32x2 sigmoid_2(f32x2 x) { return rcp_2(exp2_2(x * NLOG2E) + 1.0f); }
__device__ __forceinline__ f32x2 gelu_arg_2(f32x2 x) { return x * ((x * x) * (NLOG2E * 1.5957691216057308f * 0.044715f) + (NLOG2E * 1.5957691216057308f)); }
template <int T> __device__ __forceinline__ f32x2 act2(f32x2 a) {
    if (T == 0) return a * sigmoid_2(a);
    if (T == 1) return a * rcp_2(exp2_2(gelu_arg_2(a)) + 1.0f);
    return sigmoid_2(a);
}
template <int T  > __device__ __forceinline__ void epi_pair(const f32x4 (&acc)[2][2][4][2], const f32x4 (&bv)[2][2], bf16_t* O, int row0) {
#pragma unroll
    for (int ai = 0; ai < 2; ++ai)
#pragma unroll
        for (int m = 0; m < 4; ++m) {
            bf16_t* rowp = O + (size_t)(row0 + ai * HALF + m * 16) * DM;
            unsigned wv[4];
#pragma unroll
            for (int n = 0; n < 2; ++n) { const f32x4 a4 = acc[ai][0][m][n] + bv[0][n], g4 = acc[ai][1][m][n] + bv[1][n];
#pragma unroll
                for (int hh = 0; hh < 2; ++hh) {
                    const f32x2 a = hh ? a4.zw : a4.xy, g = hh ? g4.zw : g4.xy;
                    f32x2 o;
                    if (T == 0) o = a * sigmoid_2(g);
                    else o = (a * g) * rcp_2((exp2_2(gelu_arg_2(a)) + 1.0f) * (exp2_2(g * NLOG2E) + 1.0f));
                    wv[2 * n + hh] = pk2(o.x, o.y);
                } }
            u32x4 w; w.x = wv[0]; w.y = wv[1]; w.z = wv[2]; w.w = wv[3];
            *(u32x4*)rowp = w;
        }
}
template <int T  > __device__ __forceinline__ void epi_solo(const f32x4 (&acc)[2][2][4][2], const f32x4 (&bv)[2][2], bf16_t* O, int row0, float* vstat, int fq) {
#pragma unroll
    for (int ai = 0; ai < 2; ++ai)
#pragma unroll
        for (int m = 0; m < 4; ++m) {
            const int row = row0 + ai * HALF + m * 16;
            bf16_t* rowp = O + (size_t)row * DM;
            f32x2 s1v = {0.f, 0.f}, s2v = {0.f, 0.f};
#pragma unroll
            for (int bj = 0; bj < 2; ++bj) {
                unsigned wv[4];
#pragma unroll
                for (int n = 0; n < 2; ++n) { const f32x4 a4 = acc[ai][bj][m][n] + bv[bj][n];
#pragma unroll
                    for (int hh = 0; hh < 2; ++hh) { const f32x2 o = act2<T>(hh ? a4.zw : a4.xy); if (T == 1) { s1v += o; s2v += o * o; } wv[2 * n + hh] = pk2(o.x, o.y); } }
                u32x4 w; w.x = wv[0]; w.y = wv[1]; w.z = wv[2]; w.w = wv[3];
                *(u32x4*)(rowp + bj * HALF) = w;
            }
            if (T == 1) {
                float s1 = s1v.x + s1v.y, s2 = s2v.x + s2v.y;
                s1 += __shfl_xor(s1, 16); s1 += __shfl_xor(s1, 32); s2 += __shfl_xor(s2, 16); s2 += __shfl_xor(s2, 32);
                if (fq == 0) { __hip_atomic_fetch_add(vstat + 2 * row, s1, __ATOMIC_RELAXED, __HIP_MEMORY_SCOPE_AGENT); __hip_atomic_fetch_add(vstat + 2 * row + 1, s2, __ATOMIC_RELAXED, __HIP_MEMORY_SCOPE_AGENT); }
            }
        }
}
struct EpiP1 {
    static constexpr bool PERM = true, TWICE = true;
    const LAS float* biasP; unsigned char* ws;
    __device__ __forceinline__ bool operator()(f32x4 (&acc)[2][2][4][2], const Unit& u, int wr, int wc, int fr, int fq) const {
        const int tile = u.pn;
        const int row0 = u.pm * BM + wr * 64 + fr, qc = wc * 32 + 8 * fq;
        f32x4 bv[2][2];
#pragma unroll
        for (int bj = 0; bj < 2; ++bj)
#pragma unroll
            for (int n = 0; n < 2; ++n) bv[bj][n] = *(const LAS f32x4*)(biasP + tile * 256 + bj * HALF + qc + 4 * n);
        if (tile < 8) epi_pair<0>(acc, bv, (bf16_t*)(ws + WS_H) + (tile & 7) * 128 + qc, row0);
        else if (tile < 16) epi_pair<1>(acc, bv, (bf16_t*)(ws + WS_UB) + (tile & 7) * 128 + qc, row0);
        else if (tile < 20) epi_solo<0>(acc, bv, (bf16_t*)(ws + WS_SA) + (tile & 3) * 256 + qc, row0, nullptr, fq);
        else if (tile < 24) epi_solo<1>(acc, bv, (bf16_t*)(ws + WS_V) + (tile & 3) * 256 + qc, row0, (float*)(ws + WS_VSTAT), fq);
        else epi_solo<2>(acc, bv, (bf16_t*)(ws + (tile < 28 ? WS_GA : WS_GB)) + (tile & 3) * 256 + qc, row0, nullptr, fq);
        return false;
    }
};

struct EpiP3 {
    static constexpr bool PERM = true, TWICE = false;
    const bf16_t *GA, *GB; bf16_t* MIX;
    __device__ __forceinline__ bool operator()(f32x4 (&acc)[2][2][4][2], const Unit& u, int wr, int wc, int fr, int fq) const {
        const int row0 = u.pm * BM + wr * 64 + fr, col0 = u.pn * BM + wc * 32 + 8 * fq;
        if (u.kind == 0) {
#pragma unroll
            for (int ai = 0; ai < 2; ++ai)
#pragma unroll
                for (int m = 0; m < 4; ++m) {
                    const size_t ro = (size_t)(row0 + ai * HALF + m * 16) * DM + col0;
#pragma unroll
                    for (int bj = 0; bj < 2; ++bj) {
                        const u32x4 gb = *(const u32x4*)(GB + ro + bj * HALF), ga = *(const u32x4*)(GA + ro + bj * HALF);
                        const float b[8] = {bf_lo(gb.x), bf_hi(gb.x), bf_lo(gb.y), bf_hi(gb.y), bf_lo(gb.z), bf_hi(gb.z), bf_lo(gb.w), bf_hi(gb.w)};
                        const float a[8] = {bf_lo(ga.x), bf_hi(ga.x), bf_lo(ga.y), bf_hi(ga.y), bf_lo(ga.z), bf_hi(ga.z), bf_lo(ga.w), bf_hi(ga.w)};
#pragma unroll
                        for (int n = 0; n < 2; ++n)
#pragma unroll
                            for (int j = 0; j < 4; ++j) acc[ai][bj][m][n][j] *= a[4 * n + j] * __builtin_amdgcn_rcpf(b[4 * n + j]);
                    }
                }
            return true;
        }
#pragma unroll
        for (int ai = 0; ai < 2; ++ai)
#pragma unroll
            for (int m = 0; m < 4; ++m) {
                const size_t ro = (size_t)(row0 + ai * HALF + m * 16) * DM + col0;
#pragma unroll
                for (int bj = 0; bj < 2; ++bj) {
                    const u32x4 gb = *(const u32x4*)(GB + ro + bj * HALF);
                    const float b[8] = {bf_lo(gb.x), bf_hi(gb.x), bf_lo(gb.y), bf_hi(gb.y), bf_lo(gb.z), bf_hi(gb.z), bf_lo(gb.w), bf_hi(gb.w)};
                    float o[8];
#pragma unroll
                    for (int n = 0; n < 2; ++n)
#pragma unroll
                        for (int j = 0; j < 4; ++j) o[4 * n + j] = acc[ai][bj][m][n][j] * b[4 * n + j];
                    u32x4 w; w.x = pk2(o[0], o[1]); w.y = pk2(o[2], o[3]); w.z = pk2(o[4], o[5]); w.w = pk2(o[6], o[7]);
                    *(u32x4*)(MIX + ro + bj * HALF) = w;
                }
            }
        return false;
    }
};

struct EpiP4 {
    static constexpr bool PERM = false, TWICE = false;
    const float *x, *bo; float* out; float* stat;
    __device__ __forceinline__ bool operator()(f32x4 (&acc)[2][2][4][2], const Unit& u, int wr, int wc, int fr, int fq) const {
        const int row0 = u.pm * BM + wr * 64 + fr, col0 = u.pn * BM + wc * 32 + 4 * fq;
        f32x4 bv[2][2];
#pragma unroll
        for (int bj = 0; bj < 2; ++bj)
#pragma unroll
            for (int n = 0; n < 2; ++n) bv[bj][n] = *(const f32x4*)(bo + col0 + bj * HALF + n * 16);
#pragma unroll
        for (int ai = 0; ai < 2; ++ai)
#pragma unroll
            for (int m = 0; m < 4; ++m) {
                const int row = row0 + ai * HALF + m * 16;
                const size_t ro = (size_t)row * DM + col0;
                float s1 = 0.f, s2 = 0.f;
#pragma unroll
                for (int bj = 0; bj < 2; ++bj)
#pragma unroll
                    for (int n = 0; n < 2; ++n) {
                        const f32x4 xv = *(const f32x4*)(x + ro + bj * HALF + n * 16);
                        const f32x4 y = acc[ai][bj][m][n] + bv[bj][n] + ALPHA * xv;
                        *(f32x4*)(out + ro + bj * HALF + n * 16) = y;
                        s1 += (y[0] + y[1]) + (y[2] + y[3]); s2 += (y[0] * y[0] + y[1] * y[1]) + (y[2] * y[2] + y[3] * y[3]);
                    }
                s1 += __shfl_xor(s1, 16); s1 += __shfl_xor(s1, 32); s2 += __shfl_xor(s2, 16); s2 += __shfl_xor(s2, 32);
                if (fq == 0) { __hip_atomic_fetch_add(stat + 2 * row, s1, __ATOMIC_RELAXED, __HIP_MEMORY_SCOPE_AGENT); __hip_atomic_fetch_add(stat + 2 * row + 1, s2, __ATOMIC_RELAXED, __HIP_MEMORY_SCOPE_AGENT); }
            }
        return false;
    }
};

#define XB_TMO      128
#define XB_XCNT(j)  (256  + 64 * (j))
#define XB_XSUB(j)  (1280 + 64 * (j))
#define XB_XGEN(j)  (2304 + 64 * (j))
#define XB_TOP      3328
#define XB_TOPGEN   3392
#define XCD_BAR_WORDS 3456
#define XB_SPIN_CAP (1u << 18)
__device__ __forceinline__ unsigned xb_ld(unsigned* p)              { return __hip_atomic_load(p, __ATOMIC_RELAXED, __HIP_MEMORY_SCOPE_AGENT); }
__device__ __forceinline__ unsigned xb_add(unsigned* p, unsigned v) { return __hip_atomic_fetch_add(p, v, __ATOMIC_RELAXED, __HIP_MEMORY_SCOPE_AGENT); }
__device__ __forceinline__ unsigned xb_xcc_id() { return (unsigned)__builtin_amdgcn_s_getreg((3 << 11) | 20) & 0xFu; }
#define XB_SPIN(cond, bar) do { unsigned _sp = 0; while (cond) { __builtin_amdgcn_s_sleep(1); \
    if ((++_sp & 255u) == 0u) { if (xb_ld(&(bar)[XB_TMO])) break; if (_sp > XB_SPIN_CAP) { atomicAdd(&(bar)[XB_TMO], 1u); break; } } } } while (0)
struct XcdBarrier { unsigned* bar; unsigned x; };
__device__ __forceinline__ XcdBarrier xcd_barrier_post(unsigned* bar) {
    XcdBarrier b; b.bar = bar; b.x = xb_xcc_id();
    if (threadIdx.x == 0) (void)xb_add(&bar[XB_XCNT(b.x)], 1u);
    return b;
}
__device__ __forceinline__ void xcd_barrier_complete(unsigned* bar, unsigned x, unsigned& nloc, unsigned& nx) {
    const unsigned G = gridDim.x * gridDim.y * gridDim.z;
    unsigned sum, cnt, mine, sp = 0u;
    for (;;) {
        sum = 0u; cnt = 0u; mine = 0u;
#pragma unroll
        for (unsigned j = 0; j < 16; ++j) { const unsigned c = xb_ld(&bar[XB_XCNT(j)]); sum += c; cnt += (c > 0u) ? 1u : 0u; mine = (j == x) ? c : mine; }
        if (sum == G) break;
        __builtin_amdgcn_s_sleep(1);
        if ((++sp & 255u) == 0u) { if (xb_ld(&bar[XB_TMO])) break; if (sp > XB_SPIN_CAP) { atomicAdd(&bar[XB_TMO], 1u); break; } }
    }
    nloc = mine > 0u ? mine : 1u; nx = cnt > 0u ? cnt : 1u;
}
__device__ __forceinline__ void xcd_barrier(const XcdBarrier& b) {
    asm volatile("s_waitcnt vmcnt(0)" ::: "memory");
    __syncthreads();
    if (threadIdx.x == 0) {
        unsigned* bar = b.bar;
        __builtin_amdgcn_s_waitcnt(0);
        unsigned* mine = bar + XCD_BAR_WORDS + 2 * blockIdx.x;
        unsigned nloc = mine[0], nx = mine[1];
        if (nloc == 0u) { xcd_barrier_complete(bar, b.x, nloc, nx); mine[0] = nloc; mine[1] = nx; }
        const unsigned old = xb_add(&bar[XB_XSUB(b.x)], 1u);
        const unsigned gen = old / nloc;
        if (old + 1u == (gen + 1u) * nloc) {
            __builtin_amdgcn_fence(__ATOMIC_RELEASE, "agent");
            asm volatile("s_waitcnt vmcnt(0)" ::: "memory");
            const unsigned og = xb_add(&bar[XB_TOP], 1u);
            const unsigned tg = og / nx;
            if (og + 1u == (tg + 1u) * nx) xb_add(&bar[XB_TOPGEN], 1u);
            else XB_SPIN(xb_ld(&bar[XB_TOPGEN]) == tg, bar);
            __builtin_amdgcn_fence(__ATOMIC_ACQUIRE, "agent");
            xb_add(&bar[XB_XGEN(b.x)], 1u);
            asm volatile("s_waitcnt vmcnt(0)" ::: "memory");
        } else {
            XB_SPIN(xb_ld(&bar[XB_XGEN(b.x)]) == gen, bar);
            __builtin_amdgcn_fence(__ATOMIC_ACQUIRE, "agent");
            asm volatile("s_waitcnt vmcnt(0)" ::: "memory");
        }
    }
    __syncthreads();
}

template <bool PERMUTE>
__device__ __forceinline__ void p0_transpose_item(const float* W, int K, int N, bf16_t* WT, LAS float* scr, int item, int lane) {
    const int nblk = N / 32, kb = item / nblk, nb = item % nblk, k0 = 64 * kb, n0 = 32 * nb;
    const int src0 = PERMUTE ? orig_col(n0) : n0;
    float wv[32];
#pragma unroll
    for (int i = 0; i < 32; ++i) wv[i] = W[(size_t)(k0 + 2 * i + (lane >> 5)) * N + src0 + (lane & 31)];
#pragma unroll
    for (int i = 0; i < 32; ++i) scr[(2 * i + (lane >> 5)) * 33 + (lane & 31)] = wv[i];
    asm volatile("s_waitcnt lgkmcnt(0)" ::: "memory");
    const int c = lane & 7;
#pragma unroll
    for (int j = 0; j < 4; ++j) { const int n = (lane >> 3) + 8 * j; const LAS float* s = scr + (8 * c) * 33 + n;
        u32x4 o; o.x = pk2(s[0 * 33], s[1 * 33]); o.y = pk2(s[2 * 33], s[3 * 33]); o.z = pk2(s[4 * 33], s[5 * 33]); o.w = pk2(s[6 * 33], s[7 * 33]);
        *(u32x4*)(WT + (size_t)(n0 + n) * K + k0 + 8 * c) = o; }
    asm volatile("s_waitcnt lgkmcnt(0)" ::: "memory");
}

__device__ __forceinline__ void p0_prologue(const Args& a, LAS unsigned char* lds, int tid, int wave, int lane) {
    unsigned char* ws = a.ws;
    const size_t gt = (size_t)blockIdx.x * 512 + tid, GT = (size_t)gridDim.x * 512;
    LAS float* scr = (LAS float*)(lds + wave * 16384);
    const int gw = blockIdx.x * 8 + wave, NGW = gridDim.x * 8;
    constexpr int I_IN = (DM / 64) * (DIN / 32), I_SQ = (DM / 64) * (DM / 32);
    for (int it = gw; it < I_IN + 3 * I_SQ; it += NGW) {
        int r = it;
        if (r < I_IN) { p0_transpose_item<true>(a.in[1], DM, DIN, (bf16_t*)(ws + WS_WIN), scr, r, lane); continue; } r -= I_IN;
        if (r < I_SQ) { p0_transpose_item<false>(a.in[11], DM, DM, (bf16_t*)(ws + WS_WPA), scr, r, lane); continue; } r -= I_SQ;
        if (r < I_SQ) { p0_transpose_item<false>(a.in[12], DM, DM, (bf16_t*)(ws + WS_WPB), scr, r, lane); continue; } r -= I_SQ;
        p0_transpose_item<false>(a.in[13], DM, DM, (bf16_t*)(ws + WS_WO), scr, r, lane);
    }
    if (gt < 8 * 128 * 128) { const int t = (int)(gt >> 7) & 127, s = (int)gt & 127; const float w = a.in[9][gt]; ((bf16_t*)(ws + WS_WS))[gt] = (s <= t) ? (bf16_t)(pk2(w, 0.f) & 0xffffu) : (bf16_t)0; }
    if (gt < DIN) ((float*)(ws + WS_BIAS))[gt] = a.in[2][orig_col((int)gt)];
    if (gt < 2 * NTOK) { ((float*)(ws + WS_STAT))[gt] = 0.f; ((float*)(ws + WS_VSTAT))[gt] = 0.f; }
    const f32x4* x4 = (const f32x4*)a.in[0]; u32x4* xb = (u32x4*)(ws + WS_XB);
    constexpr size_t NX = (size_t)NTOK * DM / 8;
    size_t i = gt;
    for (; i + 3 * GT < NX; i += 4 * GT) {
        f32x4 p[4], q[4];
#pragma unroll
        for (int k = 0; k < 4; ++k) { p[k] = __builtin_nontemporal_load(x4 + 2 * (i + k * GT)); q[k] = __builtin_nontemporal_load(x4 + 2 * (i + k * GT) + 1); }
#pragma unroll
        for (int k = 0; k < 4; ++k) { u32x4 o; o.x = pk2(p[k][0], p[k][1]); o.y = pk2(p[k][2], p[k][3]); o.z = pk2(q[k][0], q[k][1]); o.w = pk2(q[k][2], q[k][3]); xb[i + k * GT] = o; }
    }
    for (; i < NX; i += GT) {
        const f32x4 p = x4[2 * i], q = x4[2 * i + 1];
        u32x4 o; o.x = pk2(p[0], p[1]); o.y = pk2(p[2], p[3]); o.z = pk2(q[0], q[1]); o.w = pk2(q[2], q[3]);
        xb[i] = o;
    }
}


template <int O, int N> __device__ __forceinline__ void tr_step(float (&v)[32], int lane) {
    const bool up = (lane & O) != 0;
#pragma unroll
    for (int i = 0; i < N; ++i) { const float send = up ? v[i] : v[i + N]; const float keep = up ? v[i + N] : v[i]; v[i] = keep + __shfl_xor(send, O); }
}
template <int O, int N> __device__ __forceinline__ void tr_step16(float (&v)[16], int lane) {
    const bool up = (lane & O) != 0;
#pragma unroll
    for (int i = 0; i < N; ++i) { const float send = up ? v[i] : v[i + N]; const float keep = up ? v[i + N] : v[i]; v[i] = keep + __shfl_xor(send, O); }
}
__device__ __forceinline__ float tr_reduce16(float (&v)[16], int lane) {
    tr_step16<32, 8>(v, lane); tr_step16<16, 4>(v, lane); tr_step16<8, 2>(v, lane); tr_step16<4, 1>(v, lane);
    float r = v[0]; r += __shfl_xor(r, 2); r += __shfl_xor(r, 1); return r;
}
__device__ __forceinline__ float tr_reduce32(float (&v)[32], int lane) {
    tr_step<32, 16>(v, lane); tr_step<16, 8>(v, lane); tr_step<8, 4>(v, lane); tr_step<4, 2>(v, lane); tr_step<2, 1>(v, lane);
    return v[0] + __shfl_xor(v[0], 1);
}

__device__ __forceinline__ void p2_conv(const Args& a, int chunk, int item0, int nitems  , int lane, bool dummy = false) {
    const bf16_t* H = (const bf16_t*)(a.ws + WS_H); bf16_t* SA = (bf16_t*)(a.ws + WS_SA);
    const float *conv_w = a.in[3], *conv_b = a.in[4], *gn_g = a.in[5], *gn_b = a.in[6];
    const bool has_prev = (chunk & 15) != 0;
    const long R0 = (long)chunk * 128;
    __builtin_amdgcn_s_setprio(2);
#pragma unroll 1
    for (int it = item0; it < item0 + nitems; ++it) {
        const int cg0 = (it >> 1) * 128, c = cg0 + 2 * lane, tb0 = (it & 1) * 64;
        const bool hist = has_prev || tb0 > 0;
        const char* Hg = (const char*)(H + (R0 + tb0) * DM + cg0); char* Sg = (char*)(SA + (R0 + tb0) * DM + cg0); char* Og = dummy ? (char*)((bf16_t*)(a.ws + WS_XB) + (R0 + tb0) * DM + cg0) : Sg;
        const unsigned lo = (unsigned)lane * 4u;
#define HROW(r) (*(const unsigned*)(Hg + (long)(r) * (DM * 2) + lo))
#define SROW(r) (*(unsigned*)(Sg + (long)(r) * (DM * 2) + lo))
        f32x2 w[31];
#pragma unroll
        for (int j = 0; j < 31; ++j) w[j] = *(const f32x2*)(conv_w + j * DM + c);
        unsigned win[38];
#pragma unroll
        for (int k = 0; k < 30; ++k) { win[k] = 0u; if (hist) win[k] = HROW(k - 30); }
#pragma unroll
        for (int k = 0; k < 8; ++k) win[30 + k] = HROW(k);
#pragma unroll 1
        for (int sl = 0; sl < 8; ++sl) {
            const int t0 = sl * 8;
            unsigned nxt[8], sraw[8];
            const int tn = sl < 7 ? t0 + 8 : t0;
#pragma unroll
            for (int k = 0; k < 8; ++k) nxt[k] = HROW(tn + k);
#pragma unroll
            for (int k = 0; k < 8; ++k) sraw[k] = SROW(t0 + k);
            const f32x2 cb = *(const f32x2*)(conv_b + c);
            f32x2 acc[8];
#pragma unroll
            for (int t = 0; t < 8; ++t) acc[t] = (f32x2){0.f, 0.f};
#pragma unroll
            for (int idx = 0; idx < 38; ++idx) { const f32x2 hv = {bf_lo(win[idx]), bf_hi(win[idx])};
#pragma unroll
                for (int t = 0; t < 8; ++t) { const int j = idx - t; if (j >= 0 && j <= 30) acc[t] += w[j] * hv; } }
            const f32x2 gg = *(const f32x2*)(gn_g + c), gb = *(const f32x2*)(gn_b + c);
            float q[16];
#pragma unroll
            for (int t = 0; t < 8; ++t) { acc[t] += cb; q[2 * t] = acc[t].x + acc[t].y; q[2 * t + 1] = acc[t].x * acc[t].x + acc[t].y * acc[t].y; }
            const float tot = tr_reduce16(q, lane);
            const float oth = __shfl_xor(tot, 4);
            const bool issq = (lane & 4) != 0;
            const float s1 = issq ? oth : tot, s2 = issq ? tot : oth;
            const float mean = s1 * (1.f / 128.f), var = fmaxf(s2 * (1.f / 128.f) - mean * mean, 0.f), rstd = __builtin_amdgcn_rsqf(var + LN_EPS);
#pragma unroll
            for (int t = 0; t < 8; ++t) {
                const float mt = __int_as_float(__builtin_amdgcn_readlane(__float_as_int(mean), 8 * t)), rt = __int_as_float(__builtin_amdgcn_readlane(__float_as_int(rstd), 8 * t));
                const float y0 = (acc[t].x - mt) * rt * gg.x + gb.x, y1 = (acc[t].y - mt) * rt * gg.y + gb.y;
                *(unsigned*)(Og + (long)(t0 + t) * (DM * 2) + lo) = pk2(fsilu(y0) * bf_lo(sraw[t]), fsilu(y1) * bf_hi(sraw[t]));
            }
#pragma unroll
            for (int k = 0; k < 30; ++k) win[k] = win[k + 8];
#pragma unroll
            for (int k = 0; k < 8; ++k) win[30 + k] = nxt[k];
        }
#undef HROW
#undef SROW
    }
    __builtin_amdgcn_s_setprio(0);
}

__device__ __forceinline__ void p2_gmlp(const Args& a, LAS unsigned char* lds, int chunk, int gw  , int lane, bool dummy = false) {
    const bf16_t* V = (const bf16_t*)(a.ws + WS_V); bf16_t* UB = (bf16_t*)(a.ws + WS_UB); const bf16_t* WsB = (const bf16_t*)(a.ws + WS_WS);
    const float* vstat = (const float*)(a.ws + WS_VSTAT);
    const float *ln_g = a.in[7], *ln_b = a.in[8], *b_sp = a.in[10];
    LAS unsigned char* vt = lds + gw * 32768;
    LAS f32x2* st = (LAS f32x2*)(lds + 4 * 32768 + gw * 1024);
    const long R0 = (long)chunk * 128;
    const int fr = lane & 15, fq = lane >> 4;
#pragma unroll
    for (int k = 0; k < 2; ++k) { const int t = lane + 64 * k; const f32x2 sv = *(const f32x2*)(vstat + 2 * (R0 + t));
        const float mean = sv.x * (1.f / 1024.f), var = fmaxf(sv.y * (1.f / 1024.f) - mean * mean, 0.f), rstd = __builtin_amdgcn_rsqf(var + LN_EPS);
        st[t] = (f32x2){rstd, -mean * rstd}; }
#pragma unroll 1
    for (int hh = 0; hh < 2; ++hh) {
        const int h = 2 * gw + hh;
        const int d8 = lane & 15, sq = lane >> 4;
        const f32x4 g0 = *(const f32x4*)(ln_g + h * 128 + d8 * 8), g1 = *(const f32x4*)(ln_g + h * 128 + d8 * 8 + 4);
        const f32x4 e0 = *(const f32x4*)(ln_b + h * 128 + d8 * 8), e1 = *(const f32x4*)(ln_b + h * 128 + d8 * 8 + 4);
        const float gk[8] = {g0[0], g0[1], g0[2], g0[3], g1[0], g1[1], g1[2], g1[3]}, ek[8] = {e0[0], e0[1], e0[2], e0[3], e1[0], e1[1], e1[2], e1[3]};
#pragma unroll 1
        for (int it = 0; it < 4; ++it) {
            const int sg = it * 4 + sq;
            u32x4 raw[8];
#pragma unroll
            for (int e = 0; e < 8; ++e) raw[e] = *(const u32x4*)(V + (R0 + sg * 8 + e) * DM + h * 128 + d8 * 8);
            float val[8][8];
#pragma unroll
            for (int e = 0; e < 8; ++e) { const f32x2 sc = st[sg * 8 + e];
#pragma unroll
                for (int k = 0; k < 4; ++k) { val[e][2 * k] = (bf_lo(raw[e][k]) * sc.x + sc.y) * gk[2 * k] + ek[2 * k]; val[e][2 * k + 1] = (bf_hi(raw[e][k]) * sc.x + sc.y) * gk[2 * k + 1] + ek[2 * k + 1]; } }
#pragma unroll
            for (int k = 0; k < 8; ++k) { const int d = d8 * 8 + k;
                u32x4 o; o.x = pk2(val[0][k], val[1][k]); o.y = pk2(val[2][k], val[3][k]); o.z = pk2(val[4][k], val[5][k]); o.w = pk2(val[6][k], val[7][k]);
                *(LAS u32x4*)(vt + d * 256 + ((sg + d + (d >> 3)) & 15) * 16) = o; }
        }
#pragma unroll 1
        for (int tb = 0; tb < 4; ++tb) {
            f32x4 acc[2][8];
#pragma unroll
            for (int mi = 0; mi < 2; ++mi)
#pragma unroll
                for (int ni = 0; ni < 8; ++ni) acc[mi][ni] = (f32x4){0.f, 0.f, 0.f, 0.f};
            bf16x8 wf[4][2];
#pragma unroll
            for (int ks = 0; ks < 4; ++ks)
#pragma unroll
                for (int mi = 0; mi < 2; ++mi) { const int kk = ks <= tb ? ks : tb;
                    wf[ks][mi] = *(const bf16x8*)(WsB + (size_t)((h * 128 + 32 * tb + 16 * mi + fr) * 128 + kk * 32 + fq * 8)); }
#pragma unroll
            for (int ks = 0; ks < 4; ++ks) {
                if (ks <= tb) {
                    bf16x8 vf[8];
#pragma unroll
                    for (int ni = 0; ni < 8; ++ni) { const int dd = 16 * ni + fr; vf[ni] = *(const LAS bf16x8*)(vt + dd * 256 + (((ks * 4 + fq) + dd + (dd >> 3)) & 15) * 16); }
#pragma unroll
                    for (int mi = 0; mi < 2; ++mi)
#pragma unroll
                        for (int ni = 0; ni < 8; ++ni) acc[mi][ni] = __builtin_amdgcn_mfma_f32_16x16x32_bf16(vf[ni], wf[ks][mi], acc[mi][ni], 0, 0, 0);
                }
            }
#pragma unroll
            for (int mi = 0; mi < 2; ++mi) {
                const int t = 32 * tb + 16 * mi + fr;
                const float bsp = b_sp[h * 128 + t];
                u32x2* prow = (u32x2*)(UB + (R0 + t) * DM + h * 128 + 4 * fq);
                u32x2 ub[8];
#pragma unroll
                for (int ni = 0; ni < 8; ++ni) ub[ni] = prow[4 * ni];
#pragma unroll
                for (int ni = 0; ni < 8; ++ni) {
                    u32x2 o; o.x = pk2((acc[mi][ni][0] + bsp) * bf_lo(ub[ni].x), (acc[mi][ni][1] + bsp) * bf_hi(ub[ni].x));
                    o.y = pk2((acc[mi][ni][2] + bsp) * bf_lo(ub[ni].y), (acc[mi][ni][3] + bsp) * bf_hi(ub[ni].y));
                    (dummy ? (u32x2*)((bf16_t*)(a.ws + WS_XB) + (R0 + t) * DM + h * 128 + 4 * fq) : prow)[4 * ni] = o;
                }
            }
        }
    }
}

__device__ __forceinline__ void p5_ln(const Args& a, int wave, int lane) {
    const float* stat = (const float*)(a.ws + WS_STAT);
    const f32x4* g4 = (const f32x4*)a.in[15]; const f32x4* b4 = (const f32x4*)a.in[16];
    f32x4 gg[4], bb[4];
#pragma unroll
    for (int j = 0; j < 4; ++j) { gg[j] = g4[lane + 64 * j]; bb[j] = b4[lane + 64 * j]; }
    for (int row = blockIdx.x * 8 + wave; row < NTOK; row += gridDim.x * 8) {
        const float s1 = stat[2 * row], s2 = stat[2 * row + 1];
        const float mean = s1 * (1.f / 1024.f), var = fmaxf(s2 * (1.f / 1024.f) - mean * mean, 0.f), rstd = __builtin_amdgcn_rsqf(var + LN_EPS);
        f32x4* p = (f32x4*)(a.out + (size_t)row * DM) + lane;
        f32x4 v[4];
#pragma unroll
        for (int j = 0; j < 4; ++j) v[j] = p[64 * j];
#pragma unroll
        for (int j = 0; j < 4; ++j) p[64 * j] = (v[j] - mean) * rstd * gg[j] + bb[j];
    }
}

__global__ void __launch_bounds__(512) fwd_megakernel(Args a) {
    extern __shared__ __attribute__((aligned(16))) unsigned char lds_raw[];
    LAS unsigned char* lds = (LAS unsigned char*)lds_raw;
    const int tid = threadIdx.x, lane = tid & 63, wave = __builtin_amdgcn_readfirstlane(tid >> 6);
    const int G = gridDim.x, c = blockIdx.x;
    unsigned char* ws = a.ws;
    const int lo = a.ph_lo, hi = a.ph_hi;
#define IN(k) (lo <= (k) && (k) < hi)
#ifdef PROBE_PHASE
    unsigned long long tstamp[7]; int nst = 0;
#define STAMP() do { tstamp[nst++] = __builtin_amdgcn_s_memrealtime(); } while (0)
#else
#define STAMP() do {} while (0)
#endif
    const XcdBarrier gbar = xcd_barrier_post((unsigned*)(a.ws + WS_CTL));
#define SEAM(k) do { if (IN(k) && IN((k) + 1)) xcd_barrier(gbar); STAMP(); } while (0)
    STAMP();

    if (IN(0)) { p0_prologue(a, lds, tid, wave, lane); }
    SEAM(0);
    if (IN(1)) {
        SchedSimple S{(const char*)(ws + WS_XB), (const char*)(ws + WS_WIN), NTOK / BM, DIN / BM, G, c};
        LAS float* lbias = (LAS float*)(lds + BIAS_OFF);
        for (int i = tid; i < DIN; i += 512) lbias[i] = a.in[2][orig_col(i)];
        __syncthreads();
        EpiP1 E{lbias, ws};
        gemm_phase(lds, S, E);
    }
    SEAM(1);
    if (IN(2)) {
        for (int chunk = c; chunk < NTOK / 128; chunk += G) {
#if defined(PROBE_GMLP2X)
            if (wave < 4) { p2_gmlp(a, lds, chunk, wave, lane, true); p2_gmlp(a, lds, chunk, wave, lane); p2_conv(a, chunk, 12 + wave, 1, lane); } else p2_conv(a, chunk, 3 * (wave - 4), 3, lane);
#elif defined(PROBE_CONV2X)
            if (wave < 4) { p2_gmlp(a, lds, chunk, wave, lane); p2_conv(a, chunk, 12 + wave, 1, lane); } else { p2_conv(a, chunk, 3 * (wave - 4), 3, lane, true); p2_conv(a, chunk, 3 * (wave - 4), 3, lane); }
#else
            if (wave < 4) p2_gmlp(a, lds, chunk, wave, lane);
            p2_conv(a, chunk, wave < 4 ? 12 + wave : 3 * (wave - 4), wave < 4 ? 1 : 3, lane);
#endif
        }
    }
    SEAM(2);
    if (IN(3)) {
        SchedDual S{(const char*)(ws + WS_SA), (const char*)(ws + WS_WPA), (const char*)(ws + WS_UB), (const char*)(ws + WS_WPB), NTOK / BM, DM / BM, G, c};
        EpiP3 E{(const bf16_t*)(ws + WS_GA), (const bf16_t*)(ws + WS_GB), (bf16_t*)(ws + WS_MIX)};
        gemm_phase(lds, S, E);
    }
    SEAM(3);
    if (IN(4)) {
        SchedSimple S{(const char*)(ws + WS_MIX), (const char*)(ws + WS_WO), NTOK / BM, DM / BM, G, c};
        EpiP4 E{a.in[0], a.in[14], a.out, (float*)(ws + WS_STAT)};
        gemm_phase(lds, S, E);
    }
    SEAM(4);
    if (IN(5)) { p5_ln(a, wave, lane); }
#ifdef PROBE_PHASE
    STAMP();
    if (c == 0 && tid == 0) {
        int bi = 0; float bm = 1e30f;
        for (int i = 0; i < 64; ++i) { const float v = fabsf(a.out[i]); if (v < bm) { bm = v; bi = i; } }
        a.out[bi] += (float)(tstamp[PROBE_PHASE + 1] - tstamp[PROBE_PHASE]) * 0.01f * (1.f / 4000.f);
    }
#endif
}

extern "C" void kernel_launch(void* const* d_in, const int* in_sizes, int n_in, void* d_out, int out_size, void* d_ws, size_t ws_size, hipStream_t stream) {
    static int grid = 0;
    if (grid == 0) {
        if (n_in != 17 || in_sizes[0] != NTOK * DM || out_size != NTOK * DM || ws_size < WS_END) {
            fprintf(stderr, "kernel_launch: unexpected shapes (n_in %d, in0 %d, out %d, ws %zu < %zu); nothing launched\n", n_in, n_in > 0 ? in_sizes[0] : -1, out_size, ws_size, (size_t)WS_END); grid = -1; return; }
        int dev = 0, cus = 0, per_cu = 0;
        (void)hipGetDevice(&dev);
        (void)hipDeviceGetAttribute(&cus, hipDeviceAttributeMultiprocessorCount, dev);
        if (hipFuncSetAttribute((const void*)fwd_megakernel, hipFuncAttributeMaxDynamicSharedMemorySize, LDS_BYTES) != hipSuccess) { fprintf(stderr, "kernel_launch: hipFuncSetAttribute failed\n"); grid = -1; return; }
        if (hipOccupancyMaxActiveBlocksPerMultiprocessor(&per_cu, (const void*)fwd_megakernel, 512, LDS_BYTES) != hipSuccess || per_cu < 1) { fprintf(stderr, "kernel_launch: occupancy query failed (%d)\n", per_cu); (void)hipGetLastError(); per_cu = 1; }
        if (per_cu > 1) per_cu = 1;
        grid = cus * per_cu;
    }
    if (grid < 0) return;
    if (hipMemsetAsync((char*)d_ws + WS_CTL, 0, CTL_BYTES, stream) != hipSuccess) { fprintf(stderr, "kernel_launch: hipMemsetAsync of the barrier words failed\n"); return; }
    Args a{};
    for (int i = 0; i < 17; ++i) a.in[i] = (const float*)d_in[i];
    a.out = (float*)d_out; a.ws = (unsigned char*)d_ws;
#if N_LAUNCHES == 1
    a.ph_lo = 0; a.ph_hi = 6;
    void* args[] = {&a};
    hipError_t e = hipLaunchCooperativeKernel((const void*)fwd_megakernel, dim3(grid), dim3(512), args, LDS_BYTES, stream);
    if (e != hipSuccess) fprintf(stderr, "cooperative launch failed: %s (grid %d)\n", hipGetErrorString(e), grid);
#else
    for (int ph = 0; ph < 6; ++ph) {
        a.ph_lo = ph; a.ph_hi = ph + 1;
        hipLaunchKernelGGL(fwd_megakernel, dim3(grid), dim3(512), LDS_BYTES, stream, a);
    }
#endif
}
```
